# Optimizing an MI355X kernel written in HIP

```python
import math
import jax
import jax.numpy as jnp
from jax import lax
import numpy as np

D_MODEL = 1024
BATCH = 2
SEQ = 8192
DEPTH = 1

CHUNK = 64
N_META = 16
D_MIX = D_MODEL
EPS = 1e-6
CONV_CH = D_MIX // 2
CONV_GROUPS = 8
CONV_K_MIX = 3
GDN_HEADS = 4
GDN_HEAD_DIM = 128
GDN_W = GDN_HEADS * GDN_HEAD_DIM
CONV_K_QKV = 4
GDN_CHUNK = CHUNK
PROJ_COLS = 3 * CONV_CH + 3 * GDN_W + GDN_W + 2 * GDN_HEADS
SPLIT_AT = [CONV_CH, 2 * CONV_CH, 3 * CONV_CH, 3 * CONV_CH + 3 * GDN_W,
            3 * CONV_CH + 4 * GDN_W, 3 * CONV_CH + 4 * GDN_W + GDN_HEADS]
N_GROUPS = 4
EXPERTS_PER_GROUP = 8
N_EXPERTS = N_GROUPS * EXPERTS_PER_GROUP
TOP_K = 2
D_EXPERT = D_MODEL // 2
EXPERT_BLOCK = 128

kernel_name = "hymba_conv_gdn_hmoe_layer"


def rms_norm(x, w):
    xf = x.astype(jnp.float32)
    y = xf * lax.rsqrt(jnp.mean(xf * xf, axis=-1, keepdims=True) + EPS)
    return (y * w.astype(jnp.float32)).astype(x.dtype)


def l2_normalize(x):
    xf = x.astype(jnp.float32)
    return xf * lax.rsqrt(jnp.sum(xf * xf, axis=-1, keepdims=True) + EPS)


def causal_depthwise_conv(x, w):
    K = w.shape[0]
    L = x.shape[1]
    xp = jnp.pad(x, ((0, 0), (K - 1, 0), (0, 0)))
    acc = xp[:, 0:L] * w[0]
    for j in range(1, K):
        acc = acc + xp[:, j:j + L] * w[j]
    return acc


def gated_delta_rule(q, k, v, g, beta):
    B, H, L, DK = q.shape
    DV = v.shape[-1]
    n_chunks = L // GDN_CHUNK

    def blocks(t):
        return t.reshape(B, H, n_chunks, GDN_CHUNK, *t.shape[3:])

    q, k, v, g, beta = (blocks(t) for t in (q * (DK ** -0.5), k, v, g, beta))
    g = jnp.cumsum(g, axis=-1)
    idx = jnp.arange(GDN_CHUNK)
    incl = idx[:, None] >= idx[None, :]
    strict = idx[:, None] > idx[None, :]
    decay = jnp.exp(jnp.where(incl, g[..., :, None] - g[..., None, :], -jnp.inf))
    kb = k * beta[..., None]
    lower = jnp.where(strict, jnp.einsum('bhnid,bhnjd->bhnij', kb, k) * decay, 0.0)
    eye = jnp.eye(GDN_CHUNK, dtype=q.dtype)
    rhs = jnp.concatenate([v * beta[..., None], kb * jnp.exp(g)[..., None]], axis=-1)
    sol = lax.linalg.triangular_solve(lower + eye, rhs, left_side=True, lower=True,
                                      unit_diagonal=True)
    u, w = sol[..., :DV], sol[..., DV:]
    intra = jnp.einsum('bhnid,bhnjd->bhnij', q, k) * decay
    g_last = g[..., -1]
    qg = q * jnp.exp(g)[..., None]
    kd = k * jnp.exp(g_last[..., None] - g)[..., None]
    a_last = jnp.exp(g_last)
    xs = tuple(jnp.moveaxis(t, 2, 0) for t in (qg, kd, u, w, intra, a_last))

    def step(S, inp):
        qg_c, kd_c, u_c, w_c, intra_c, a_c = inp
        v_new = u_c - jnp.einsum('bhik,bhkv->bhiv', w_c, S)
        o_c = (jnp.einsum('bhik,bhkv->bhiv', qg_c, S)
               + jnp.einsum('bhij,bhjv->bhiv', intra_c, v_new))
        S = S * a_c[..., None, None] + jnp.einsum('bhik,bhiv->bhkv', kd_c, v_new)
        return S, o_c

    S0 = jnp.zeros((B, H, DK, DV), q.dtype)
    _, o = lax.scan(step, S0, xs)
    return jnp.moveaxis(o, 0, 2).reshape(B, H, L, DV)


def hybrid_mixer(xn, w_in, conv_mix_w, conv_mix_norm_w, qkv_conv_w, a_log, dt_bias,
                 gdn_norm_w, w_out):
    B, L, _ = xn.shape
    proj = xn @ w_in
    gate_b, gate_c, u, qkv, z, a, b = jnp.split(proj, SPLIT_AT, axis=-1)

    y_a = gate_b * causal_depthwise_conv(gate_c * u, conv_mix_w)
    y_a = rms_norm(y_a.reshape(B, L, CONV_GROUPS, CONV_CH // CONV_GROUPS),
                   conv_mix_norm_w.reshape(CONV_GROUPS, CONV_CH // CONV_GROUPS))
    y_a = y_a.reshape(B, L, CONV_CH)

    qkv = jax.nn.silu(causal_depthwise_conv(qkv, qkv_conv_w))
    q, k, v = jnp.split(qkv, 3, axis=-1)
    q = l2_normalize(q.reshape(B, L, GDN_HEADS, GDN_HEAD_DIM))
    k = l2_normalize(k.reshape(B, L, GDN_HEADS, GDN_HEAD_DIM))
    v = v.reshape(B, L, GDN_HEADS, GDN_HEAD_DIM).astype(jnp.float32)
    beta = jax.nn.sigmoid(b.astype(jnp.float32))
    g = -jnp.exp(a_log.astype(jnp.float32)) * jax.nn.softplus(
        a.astype(jnp.float32) + dt_bias.astype(jnp.float32))
    pad = (-L) % GDN_CHUNK
    to_bhl = lambda t: jnp.pad(jnp.swapaxes(t, 1, 2),
                               [(0, 0), (0, 0), (0, pad)] + [(0, 0)] * (t.ndim - 3))
    o = gated_delta_rule(to_bhl(q), to_bhl(k), to_bhl(v), to_bhl(g), to_bhl(beta))
    o = jnp.swapaxes(o[:, :, :L], 1, 2).astype(xn.dtype)
    o = rms_norm(o, gdn_norm_w) * jax.nn.silu(z.reshape(B, L, GDN_HEADS, GDN_HEAD_DIM))
    y_b = o.reshape(B, L, GDN_W)

    return jnp.concatenate([y_a, y_b], axis=-1) @ w_out


def grouped_expert_ffn(xf, expert_idx, expert_w, w_gate, w_up, w_down):
    T, D = xf.shape
    n_assign = T * TOP_K
    n_blocks = (n_assign + N_EXPERTS * (EXPERT_BLOCK - 1) + EXPERT_BLOCK - 1) // EXPERT_BLOCK
    n_rows = n_blocks * EXPERT_BLOCK
    flat_e = expert_idx.reshape(-1).astype(jnp.int32)
    flat_w = expert_w.reshape(-1)
    flat_tok = jnp.arange(n_assign, dtype=jnp.int32) // TOP_K
    order = jnp.argsort(flat_e)
    sorted_e = flat_e[order]
    counts = jnp.bincount(flat_e, length=N_EXPERTS).astype(jnp.int32)
    padded = (counts + EXPERT_BLOCK - 1) // EXPERT_BLOCK * EXPERT_BLOCK
    pad_end = jnp.cumsum(padded)
    pad_start = pad_end - padded
    start = jnp.cumsum(counts) - counts
    dest = pad_start[sorted_e] + jnp.arange(n_assign, dtype=jnp.int32) - start[sorted_e]
    row_tok = jnp.full((n_rows,), T, jnp.int32).at[dest].set(flat_tok[order])
    row_w = jnp.zeros((n_rows,), xf.dtype).at[dest].set(flat_w[order].astype(xf.dtype))
    block_start = jnp.arange(n_blocks, dtype=jnp.int32) * EXPERT_BLOCK
    block_expert = jnp.minimum(jnp.searchsorted(pad_end, block_start, side='right'),
                               N_EXPERTS - 1).astype(jnp.int32)
    x_rows = jnp.concatenate([xf, jnp.zeros((1, D), xf.dtype)], axis=0)[row_tok]
    x_rows = x_rows.reshape(n_blocks, EXPERT_BLOCK, D)

    def expert_block(args):
        xb, e = args
        hid = jax.nn.silu(xb @ w_gate[e]) * (xb @ w_up[e])
        return hid @ w_down[e]

    y_rows = lax.map(expert_block, (x_rows, block_expert)).reshape(n_rows, D)
    out = jnp.zeros((T + 1, D), xf.dtype).at[row_tok].add(y_rows * row_w[:, None])
    return out[:T]


def hierarchical_moe(xn, w_group, b_group, w_router, b_router, w_gate, w_up, w_down):
    B, L, D = xn.shape
    xf = xn.reshape(-1, D)
    xr = xf.astype(jnp.float32)
    grp_prob = jax.nn.softmax(xr @ w_group.astype(jnp.float32) + b_group, axis=-1)
    p_grp, g_sel = lax.top_k(grp_prob, 1)
    exp_logits = jnp.einsum('td,dge->tge', xr, w_router.astype(jnp.float32)) + b_router
    exp_logits = jnp.take_along_axis(exp_logits, g_sel[:, :, None], axis=1)[:, 0]
    w_top, e_top = lax.top_k(jax.nn.softmax(exp_logits, axis=-1), TOP_K)
    w_top = w_top / jnp.sum(w_top, axis=-1, keepdims=True) * p_grp
    expert_idx = g_sel * EXPERTS_PER_GROUP + e_top
    y = grouped_expert_ffn(xf, expert_idx, w_top, w_gate, w_up, w_down)
    return y.reshape(B, L, D)


def setup_inputs(seed: int = 0) -> dict:
    key = jax.random.key(seed)
    ks = jax.random.split(key, 24)
    f32 = jnp.float32
    nrm = lambda k, shape, scale: jax.random.normal(k, shape, f32) * scale
    gain = lambda k, shape: 1.0 + 0.02 * jax.random.normal(k, shape, f32)
    dt = jnp.exp(jax.random.uniform(ks[8], (DEPTH, GDN_HEADS), f32,
                                    math.log(1e-3), math.log(1e-1)))
    dt_bias = dt + jnp.log(-jnp.expm1(-dt))
    a_log = jnp.log(jax.random.uniform(ks[7], (DEPTH, GDN_HEADS), f32, 1.0, 16.0))
    return {
        'x': jax.random.normal(ks[0], (BATCH, SEQ, D_MODEL), f32),
        'meta_tokens': nrm(ks[1], (N_META, D_MODEL), 1.0),
        'mix_norm_w': gain(ks[2], (DEPTH, D_MODEL)),
        'w_in': nrm(ks[3], (DEPTH, D_MODEL, PROJ_COLS), D_MODEL ** -0.5),
        'conv_mix_w': nrm(ks[4], (DEPTH, CONV_K_MIX, CONV_CH), CONV_K_MIX ** -0.5),
        'conv_mix_norm_w': gain(ks[5], (DEPTH, CONV_CH)),
        'qkv_conv_w': nrm(ks[6], (DEPTH, CONV_K_QKV, 3 * GDN_W), CONV_K_QKV ** -0.5),
        'a_log': a_log,
        'dt_bias': dt_bias,
        'gdn_norm_w': gain(ks[9], (DEPTH, GDN_HEAD_DIM)),
        'w_out': nrm(ks[10], (DEPTH, D_MIX, D_MODEL), D_MIX ** -0.5),
        'ffn_norm_w': gain(ks[11], (DEPTH, D_MODEL)),
        'w_group': nrm(ks[12], (DEPTH, D_MODEL, N_GROUPS), D_MODEL ** -0.5),
        'b_group': nrm(ks[13], (DEPTH, N_GROUPS), 0.01),
        'w_router': nrm(ks[14], (DEPTH, D_MODEL, N_GROUPS, EXPERTS_PER_GROUP), D_MODEL ** -0.5),
        'b_router': nrm(ks[15], (DEPTH, N_GROUPS, EXPERTS_PER_GROUP), 0.01),
        'w_gate': nrm(ks[16], (DEPTH, N_EXPERTS, D_MODEL, D_EXPERT), D_MODEL ** -0.5),
        'w_up': nrm(ks[17], (DEPTH, N_EXPERTS, D_MODEL, D_EXPERT), D_MODEL ** -0.5),
        'w_down': nrm(ks[18], (DEPTH, N_EXPERTS, D_EXPERT, D_MODEL), D_EXPERT ** -0.5),
        'final_norm_w': gain(ks[19], (D_MODEL,)),
    }


def reference(x, meta_tokens, mix_norm_w, w_in, conv_mix_w, conv_mix_norm_w, qkv_conv_w,
              a_log, dt_bias, gdn_norm_w, w_out, ffn_norm_w, w_group, b_group, w_router,
              b_router, w_gate, w_up, w_down, final_norm_w):
    B = x.shape[0]
    meta = jnp.broadcast_to(meta_tokens.astype(x.dtype)[None], (B, N_META, D_MODEL))
    h = jnp.concatenate([meta, x], axis=1)
    for layer in range(DEPTH):
        xn = rms_norm(h, mix_norm_w[layer])
        h = h + hybrid_mixer(xn, w_in[layer], conv_mix_w[layer], conv_mix_norm_w[layer],
                             qkv_conv_w[layer], a_log[layer], dt_bias[layer],
                             gdn_norm_w[layer], w_out[layer])
        xn = rms_norm(h, ffn_norm_w[layer])
        h = h + hierarchical_moe(xn, w_group[layer], b_group[layer], w_router[layer],
                                 b_router[layer], w_gate[layer], w_up[layer], w_down[layer])
    out = rms_norm(h, final_norm_w)
    return out[:, N_META:]
```

```cpp
#include <hip/hip_runtime.h>
#include <cstdio>
#include <cstdint>

#ifndef MK_N_LAUNCHES
#define MK_N_LAUNCHES 1
#endif
#ifndef MK_PROBE_P2
#define MK_PROBE_P2 0
#endif
#ifndef MK_PROBE_P3
#define MK_PROBE_P3 0
#endif
#ifndef MK_REPEAT_MASK
#define MK_REPEAT_MASK 0
#endif

#define GAS __attribute__((address_space(1)))
#define LAS __attribute__((address_space(3)))
typedef unsigned short bf16_t;
typedef short bf16x8 __attribute__((ext_vector_type(8)));
typedef float f32x4 __attribute__((ext_vector_type(4)));
typedef unsigned u32x4 __attribute__((ext_vector_type(4)));
typedef unsigned u32x2 __attribute__((ext_vector_type(2)));

constexpr int NB = 2, SEQ = 8192, NMETA = 16, DM = 1024;
constexpr int TPAD = 48, TREAL = TPAD + NMETA;
constexpr int NCHUNK = 129, LP = NCHUNK * 64;
constexpr int MR = NB * LP;
constexpr int MRP = 65 * 256;
constexpr int MT = NB * SEQ;
constexpr int NPROJ = 3584;
constexpr int PROJ_LD = 3592;
constexpr int NEXP = 32, DEXP = 512;
constexpr int ROWS_CAP = 160 * 256;
constexpr int NUNIT_GDN = 8 * NCHUNK;
constexpr float EPS = 1e-6f;
constexpr int NPHASE = 11;

constexpr size_t MiB = 1u << 20;
constexpr size_t WS_CTL = 0, CTL_ZERO_BYTES = 65536;
constexpr size_t WS_WIN = 1 * MiB;
constexpr size_t WS_WOUT = 8 * MiB;
constexpr size_t WS_SMALL = 10 * MiB;
constexpr size_t WS_RSTD1 = WS_SMALL;
constexpr size_t WS_GB = WS_RSTD1 + 128 * 1024;
constexpr size_t WS_WRF = WS_GB + 640 * 1024;
constexpr size_t WS_RSTD2 = WS_WRF + 256 * 1024;
constexpr size_t WS_EIDX = WS_RSTD2 + 64 * 1024;
constexpr size_t WS_EW = WS_EIDX + 128 * 1024;
constexpr size_t WS_SLOT = WS_EW + 128 * 1024;
constexpr size_t WS_POS = WS_SLOT + 128 * 1024;
constexpr size_t WS_RSC = WS_POS + 128 * 1024;
constexpr size_t WS_TILE = WS_RSC + 192 * 1024;
constexpr size_t WS_ALAST = WS_TILE + 4096;
constexpr size_t WS_TOKOF = WS_ALAST + 8192;
static_assert(WS_TOKOF + ROWS_CAP * 4 <= 16 * MiB, "small region");
constexpr size_t WS_XB = 16 * MiB;
constexpr size_t WS_YCAT = 48 * MiB;
constexpr size_t WS_PZ = 80 * MiB;
constexpr size_t WS_KD = 240 * MiB;
constexpr size_t WS_IN = 256 * MiB + 512 * 1024;
constexpr size_t WS_PA = 109 * MiB;
constexpr size_t WS_PQ = 158 * MiB;
constexpr size_t WS_WE = 96 * MiB + 512 * 1024;
constexpr size_t WS_WED = WS_WE + 64 * MiB;
constexpr size_t WS_XS = 16 * MiB;
constexpr size_t WS_HID = 192 * MiB + 512 * 1024;
constexpr size_t WS_SFR = 207 * MiB;
constexpr size_t WS_H1B = 232 * MiB + 512 * 1024;
constexpr size_t WS_END = 265 * MiB;
constexpr size_t DO_W = 0, DO_U = 17 * MiB, DO_QG = 34 * MiB;

constexpr int CW_BAR = 0;
constexpr int CW_CNT = 4096;
constexpr int CW_HC = 14080;

constexpr int RING_BYTES = 131072;
constexpr int LDS_BYTES = 147456;
constexpr int LDSCTL_OFF = LDS_BYTES - 3328;
constexpr int LDS_TILE_OFF = LDSCTL_OFF + 256;
constexpr int LDS_TORD_OFF = LDS_TILE_OFF + 2048;
constexpr int LDS_TVAL_OFF = LDS_TILE_OFF + 1024;
constexpr int SC_SLOT = 34816, SC_CTL = 4 * SC_SLOT;
static_assert(SC_CTL + 64 <= LDSCTL_OFF, "scan ring vs control words");

#define LDS_WAIT() asm volatile("s_waitcnt lgkmcnt(0)" ::: "memory")
#define VM_WAIT() asm volatile("s_waitcnt vmcnt(0)" ::: "memory")
#define RLX_AGENT __ATOMIC_RELAXED, __HIP_MEMORY_SCOPE_AGENT

typedef __bf16 bf16x2_t __attribute__((ext_vector_type(2)));
typedef float f32x2_t __attribute__((ext_vector_type(2)));
__device__ __forceinline__ unsigned cvt_pk_bf16(float lo, float hi) { const f32x2_t f = {lo, hi}; const bf16x2_t v = __builtin_convertvector(f, bf16x2_t); return __builtin_bit_cast(unsigned, v); }
__device__ __forceinline__ float bf_lo(unsigned u) { return __uint_as_float(u << 16); }
__device__ __forceinline__ float bf_hi(unsigned u) { return __uint_as_float(u & 0xffff0000u); }
__device__ __forceinline__ float wave_sum(float v) {
#pragma unroll
    for (int o = 1; o < 64; o <<= 1) v += __shfl_xor(v, o);
    return v;
}
__device__ __forceinline__ float silu_f(float x) { return x * __builtin_amdgcn_rcpf(1.f + __expf(-x)); }
template <class T> __device__ __forceinline__ T ld_agent(const T* p) { return __hip_atomic_load(p, RLX_AGENT); }

#define XB_TMO      128
#define XB_XCNT(j)  (256  + 64 * (j))
#define XB_XSUB(j)  (1280 + 64 * (j))
#define XB_XGEN(j)  (2304 + 64 * (j))
#define XB_TOP      3328
#define XB_TOPGEN   3392
#define XCD_BAR_WORDS 3456
#define XB_SPIN_CAP (1u << 18)
__device__ __forceinline__ unsigned xb_ld(unsigned* p)              { return __hip_atomic_load(p, __ATOMIC_RELAXED, __HIP_MEMORY_SCOPE_AGENT); }
__device__ __forceinline__ unsigned xb_add(unsigned* p, unsigned v) { return __hip_atomic_fetch_add(p, v, __ATOMIC_RELAXED, __HIP_MEMORY_SCOPE_AGENT); }
__device__ __forceinline__ unsigned xb_xcc_id() { return (unsigned)__builtin_amdgcn_s_getreg((3 << 11) | 20) & 0xFu; }
#define XB_SPIN(cond, bar) do { unsigned _sp = 0; while (cond) { __builtin_amdgcn_s_sleep(1); \
    if ((++_sp & 255u) == 0u) { if (xb_ld(&(bar)[XB_TMO])) break; if (_sp > XB_SPIN_CAP) { atomicAdd(&(bar)[XB_TMO], 1u); break; } } } } while (0)
struct XcdBarrier { unsigned* bar; unsigned x; volatile LAS unsigned* st; };
__device__ __forceinline__ XcdBarrier xcd_barrier_post(unsigned* bar, volatile LAS unsigned* st) {
    XcdBarrier b; b.bar = bar; b.x = xb_xcc_id(); b.st = st;
    if (threadIdx.x == 0) (void)xb_add(&bar[XB_XCNT(b.x)], 1u);
    return b;
}
__device__ __forceinline__ void xcd_barrier_complete(unsigned* bar, unsigned x, unsigned& nloc, unsigned& nx) {
    const unsigned G = gridDim.x * gridDim.y * gridDim.z;
    unsigned sum, cnt, mine, sp = 0u;
    for (;;) {
        sum = 0u; cnt = 0u; mine = 0u;
#pragma unroll
        for (unsigned j = 0; j < 16; ++j) { const unsigned c = xb_ld(&bar[XB_XCNT(j)]); sum += c; cnt += (c > 0u) ? 1u : 0u; mine = (j == x) ? c : mine; }
        if (sum == G) break;
        __builtin_amdgcn_s_sleep(1);
        if ((++sp & 255u) == 0u) { if (xb_ld(&bar[XB_TMO])) break; if (sp > XB_SPIN_CAP) { atomicAdd(&bar[XB_TMO], 1u); break; } }
    }
    nloc = mine > 0u ? mine : 1u; nx = cnt > 0u ? cnt : 1u;
}
__device__ __forceinline__ void xcd_barrier(const XcdBarrier& b) {
    asm volatile("s_waitcnt vmcnt(0)" ::: "memory");
    __syncthreads();
    if (threadIdx.x == 0) {
        unsigned* bar = b.bar;
        __builtin_amdgcn_s_waitcnt(0);
        unsigned nloc = b.st[0], nx = b.st[1];
        if (nloc == 0u) { xcd_barrier_complete(bar, b.x, nloc, nx); b.st[0] = nloc; b.st[1] = nx; }
        const unsigned old = xb_add(&bar[XB_XSUB(b.x)], 1u);
        const unsigned gen = old / nloc;
        if (old + 1u == (gen + 1u) * nloc) {
            __builtin_amdgcn_fence(__ATOMIC_RELEASE, "agent");
            asm volatile("s_waitcnt vmcnt(0)" ::: "memory");
            const unsigned og = xb_add(&bar[XB_TOP], 1u);
            const unsigned tg = og / nx;
            if (og + 1u == (tg + 1u) * nx) xb_add(&bar[XB_TOPGEN], 1u);
            else XB_SPIN(xb_ld(&bar[XB_TOPGEN]) == tg, bar);
            __builtin_amdgcn_fence(__ATOMIC_ACQUIRE, "agent");
            xb_add(&bar[XB_XGEN(b.x)], 1u);
            asm volatile("s_waitcnt vmcnt(0)" ::: "memory");
        } else {
            XB_SPIN(xb_ld(&bar[XB_XGEN(b.x)]) == gen, bar);
            __builtin_amdgcn_fence(__ATOMIC_ACQUIRE, "agent");
            asm volatile("s_waitcnt vmcnt(0)" ::: "memory");
        }
    }
    __syncthreads();
}

namespace pg8 {
constexpr int BM = 256, BK = 64, HALF = 128, HTB = HALF * BK * 2, NXCD = 8, WGM = 8;
__host__ __device__ __forceinline__ int lds_byte(int r, int c) { const int st = (r >> 4) * 2 + (c >> 5), rr = r & 15, cc = c & 31, ob = rr * 64 + cc * 2; return st * 1024 + (ob ^ (((ob >> 9) & 1) << 5)); }
__host__ __device__ __forceinline__ void stage_rc(int b, int& R, int& C) { const int st = b / 1024, sb = b % 1024, swz = sb ^ (((sb >> 9) & 1) << 5); R = (st >> 1) * 16 + swz / 64; C = (st & 1) * 32 + (swz % 64) / 2; }
__host__ __device__ __forceinline__ int perm32(int rho) { const int n = rho >> 4, i = rho & 15; return 8 * (i >> 2) + 4 * n + (i & 3); }

struct Unit { unsigned aoff, boff; int pm, pn; };
struct Gemm { const bf16_t* A; const bf16_t* Bt; int K; };

struct DenseOrder {
    static constexpr bool GATHER = false;
    int nM, nN, nwg, G, c; unsigned pstep;
    __device__ void init(int nM_, int nN_, int K, int G_, int c_) { nM = nM_; nN = nN_; nwg = nM * nN; G = G_; c = c_; pstep = 256u * (unsigned)K * 2u; }
    __device__ bool next(int i, Unit& u) const {
        const long L = (long)i * G + c; if (L >= nwg) return false;
        int wgid = (int)L; { const int q = nwg / NXCD, r = nwg % NXCD, xcd = wgid % NXCD, off = wgid / NXCD; wgid = (xcd < r ? xcd * (q + 1) : r * (q + 1) + (xcd - r) * q) + off; }
        const int nig = WGM * nN, gid = wgid / nig, fm = gid * WGM, gsz = (nM - fm) < WGM ? (nM - fm) : WGM;
        u.pm = fm + ((wgid % nig) % gsz); u.pn = (wgid % nig) / gsz; u.aoff = (unsigned)u.pm * pstep; u.boff = (unsigned)u.pn * pstep; return true;
    }
    __device__ __forceinline__ void a_ready(const Unit&) const {}
    __device__ __forceinline__ void done(const Unit&) const {}
};
struct MoeOrder {
    static constexpr bool GATHER = true;
    const LAS int* tile_e; const LAS int* tord; int ntiles, nN, G, c; unsigned pstep, estep;
    __device__ bool next(int i, Unit& u) const {
        const long L = (long)i * G + c; if (L >= (long)ntiles * nN) return false;
        const int rt = tord[(int)L / nN], pn = (int)L % nN; const int e = tile_e[rt];
        u.pm = rt; u.pn = pn; u.aoff = (unsigned)rt * pstep; u.boff = (unsigned)e * estep + (unsigned)pn * pstep; return true;
    }
    __device__ __forceinline__ void a_ready(const Unit&) const {}
    unsigned* hc; const int* tok;
    __device__ __forceinline__ void done(const Unit& u) const {
        asm volatile("s_waitcnt vmcnt(0)" ::: "memory");
        if ((threadIdx.x & 63) == 0) __hip_atomic_fetch_add(hc + u.pm, 1u, __ATOMIC_RELAXED, __HIP_MEMORY_SCOPE_AGENT);
    }
};
struct MoeOrderDown {
    static constexpr bool GATHER = false;
    const LAS int* tile_e; const LAS int* tord; int U, G, c, r; unsigned pstep, estep; const unsigned* hc; unsigned* tmo;
    __device__ bool next(int i, Unit& u) const {
        long L;
        if (c < r) L = 2L * (G - r) + (long)i * G + c;
        else L = i < 2 ? (long)i * (G - r) + (c - r) : 2L * (G - r) + (long)(i - 2) * G + c;
        if (L >= U) return false;
        const int rt = tord[(int)L >> 2], pn = (int)L & 3; const int e = tile_e[rt];
        u.pm = rt; u.pn = pn; u.aoff = (unsigned)rt * pstep; u.boff = (unsigned)e * estep + (unsigned)pn * pstep; return true;
    }
    __device__ __forceinline__ void a_ready(const Unit& u) const {
        if (threadIdx.x < 64) { unsigned sp = 0;
            while ((unsigned)__builtin_amdgcn_readfirstlane((int)__hip_atomic_load(hc + u.pm, __ATOMIC_RELAXED, __HIP_MEMORY_SCOPE_AGENT)) < 32u) {
                __builtin_amdgcn_s_sleep(8); if (++sp > (1u << 20)) { if (threadIdx.x == 0) __hip_atomic_store(tmo, 1u, __ATOMIC_RELAXED, __HIP_MEMORY_SCOPE_AGENT); break; } }
            __builtin_amdgcn_fence(__ATOMIC_ACQUIRE, "agent");
            asm volatile("s_waitcnt vmcnt(0)" ::: "memory"); }
        asm volatile("" ::: "memory"); __builtin_amdgcn_s_barrier(); asm volatile("" ::: "memory");
    }
    __device__ __forceinline__ void done(const Unit&) const {}
};

template <class Epi, class Sched>
__device__ __forceinline__ void gemm_phase(LAS unsigned char* lds, const Gemm g, const Sched& S, const Epi& E) {
    const int tid = threadIdx.x, wid = __builtin_amdgcn_readfirstlane(tid >> 6), lane = tid & 63, wr = wid >> 2, wc = wid & 3, fr = lane & 15, fq = lane >> 4;
    const int K = g.K, nt = K / BK;
    unsigned voffA[2], voffB[2];
#pragma unroll
    for (int i = 0; i < 2; ++i) { int R, C; stage_rc(tid * 16 + i * 8192, R, C); const int Rb = Epi::PERM ? ((R & ~31) + perm32(R & 31)) : R;
        voffA[i] = (unsigned)(R * K + C) * 2u; voffB[i] = (unsigned)(Rb * K + C) * 2u; }
    const size_t kstep = (size_t)(BK * 2);
    const size_t hstep = (size_t)HALF * K * 2;
    const unsigned ldsw = (unsigned)wid * 1024u;
    unsigned cG[2][2], nG[2][2]; int gR[2], gC[2];
    if constexpr (Sched::GATHER) {
#pragma unroll
        for (int i = 0; i < 2; ++i) { int R, C; stage_rc(tid * 16 + i * 8192, R, C); gR[i] = R; gC[i] = C * 2; } }
#define PG8_GIDX(dst, un) do { _Pragma("unroll") for (int _h = 0; _h < 2; ++_h) _Pragma("unroll") for (int _i = 0; _i < 2; ++_i) dst[_h][_i] = (unsigned)S.tok[(un).pm * 256 + 128 * _h + gR[_i]]; } while (0)
#define PG8_GOFF(dst) do { _Pragma("unroll") for (int _h = 0; _h < 2; ++_h) _Pragma("unroll") for (int _i = 0; _i < 2; ++_i) { unsigned _t = dst[_h][_i]; _t = _t < (unsigned)(MT - 1) ? _t : (unsigned)(MT - 1); \
        dst[_h][_i] = _t * (unsigned)(K * 2) + (unsigned)gC[_i]; } } while (0)
#define PG8_STAGE_G(bufoff, koff, v0, v1) do { \
        __builtin_amdgcn_global_load_lds((const unsigned*)((const char*)g.A + (koff) + (v0)), (LAS unsigned*)(lds + (bufoff) + ldsw), 16, 0, 0); \
        __builtin_amdgcn_global_load_lds((const unsigned*)((const char*)g.A + (koff) + (v1)), (LAS unsigned*)(lds + (bufoff) + ldsw + 8192), 16, 0, 0); } while (0)
    const int aoff = lds_byte(wr * 64 + fr, fq * 8), boff = lds_byte(wc * 32 + fr, fq * 8);
#define PG8_SA(b, h) (((b) * 2 + (h)) * HTB)
#define PG8_SB(b, h) ((4 + (b) * 2 + (h)) * HTB)
#define PG8_STAGE(bufoff, gbase, voff) do { _Pragma("unroll") for (int _i = 0; _i < 2; ++_i) \
        __builtin_amdgcn_global_load_lds((const unsigned*)((const char*)(gbase) + (voff)[_i]), (LAS unsigned*)(lds + (bufoff) + ldsw + _i * 8192), 16, 0, 0); } while (0)
#define PG8_LDA(dst, b, h) do { _Pragma("unroll") for (int m = 0; m < 4; ++m) _Pragma("unroll") for (int k = 0; k < 2; ++k) dst[m][k] = *(const LAS bf16x8*)(lds + PG8_SA(b, h) + aoff + m * 2048 + k * 1024); } while (0)
#define PG8_LDB(dst, b, h) do { _Pragma("unroll") for (int n = 0; n < 2; ++n) _Pragma("unroll") for (int k = 0; k < 2; ++k) dst[n][k] = *(const LAS bf16x8*)(lds + PG8_SB(b, h) + boff + n * 2048 + k * 1024); } while (0)
#define PG8_MMA(ai, bj, At, Bt) do { __builtin_amdgcn_s_setprio(1); _Pragma("unroll") for (int m = 0; m < 4; ++m) _Pragma("unroll") for (int n = 0; n < 2; ++n) _Pragma("unroll") for (int k = 0; k < 2; ++k) \
        acc[ai][bj][m][n] = __builtin_amdgcn_mfma_f32_16x16x32_bf16(Bt[n][k], At[m][k], acc[ai][bj][m][n], 0, 0, 0); __builtin_amdgcn_s_setprio(0); } while (0)
#define PG8_WAIT_V(n) asm volatile("s_waitcnt vmcnt(" #n ")" ::: "memory")
#define PG8_WAIT_L(n) asm volatile("s_waitcnt lgkmcnt(" #n ")" ::: "memory")
#define PG8_BAR __builtin_amdgcn_s_barrier()
#define PG8_SCHED __builtin_amdgcn_sched_barrier(0)
    Unit cur, nxt; int ui = 0;
    if (!S.next(0, cur)) return;
    f32x4 acc[2][2][4][2];
#pragma unroll
    for (int a = 0; a < 2; ++a)
#pragma unroll
        for (int b = 0; b < 2; ++b)
#pragma unroll
            for (int m = 0; m < 4; ++m)
#pragma unroll
                for (int n = 0; n < 2; ++n) acc[a][b][m][n] = (f32x4){0.f, 0.f, 0.f, 0.f};
    bf16x8 At[4][2], B0[2][2], B1[2][2];
    const char* cA = (const char*)g.A + cur.aoff; const char* cB = (const char*)g.Bt + cur.boff;
    S.a_ready(cur);
    if constexpr (Sched::GATHER) { PG8_GIDX(cG, cur); Unit n1; if (S.next(1, n1)) PG8_GIDX(nG, n1); else PG8_GIDX(nG, cur); PG8_GOFF(cG); PG8_GOFF(nG); }
    PG8_STAGE(PG8_SB(0, 0), cB, voffB); PG8_STAGE(PG8_SB(0, 1), cB + hstep, voffB);
    if constexpr (Sched::GATHER) { PG8_STAGE_G(PG8_SA(0, 0), 0, cG[0][0], cG[0][1]); PG8_STAGE_G(PG8_SA(0, 1), 0, cG[1][0], cG[1][1]); }
    else { PG8_STAGE(PG8_SA(0, 0), cA, voffA); PG8_STAGE(PG8_SA(0, 1), cA + hstep, voffA); }
    if (wr == 1) PG8_BAR;
    PG8_WAIT_V(2); PG8_BAR;
    PG8_STAGE(PG8_SB(1, 0), cB + kstep, voffB);
    if constexpr (Sched::GATHER) PG8_STAGE_G(PG8_SA(1, 0), kstep, cG[0][0], cG[0][1]); else PG8_STAGE(PG8_SA(1, 0), cA + kstep, voffA);
    PG8_STAGE(PG8_SB(1, 1), cB + hstep + kstep, voffB);
    PG8_WAIT_V(6); PG8_BAR;
    for (;;) {
        const bool has_next = S.next(ui + 1, nxt);
        const char* nA = has_next ? (const char*)g.A + nxt.aoff : cA; const char* nB = has_next ? (const char*)g.Bt + nxt.boff : cB;
        for (int t = 0; t < nt; t += 2) {
            const bool last = (t == nt - 2);
            const char* a1 = cA + (size_t)(t + 1) * kstep;
            const char* a2 = last ? nA : cA + (size_t)(t + 2) * kstep; const char* b2 = last ? nB : cB + (size_t)(t + 2) * kstep;
            const char* a3 = a2 + kstep; const char* b3 = b2 + kstep;
            if (last && has_next) S.a_ready(nxt);
            const size_t ko1 = (size_t)(t + 1) * kstep, ko2 = last ? 0 : (size_t)(t + 2) * kstep, ko3 = ko2 + kstep; const bool un = last && has_next;
            PG8_LDB(B0, 0, 0); PG8_LDB(B1, 0, 1); PG8_SCHED; PG8_LDA(At, 0, 0);
            if constexpr (Sched::GATHER) PG8_STAGE_G(PG8_SA(1, 1), ko1, cG[1][0], cG[1][1]); else PG8_STAGE(PG8_SA(1, 1), a1 + hstep, voffA);
            PG8_WAIT_V(8); PG8_WAIT_L(0); PG8_BAR; PG8_MMA(0, 0, At, B0); PG8_MMA(0, 1, At, B1); PG8_BAR; PG8_SCHED;
            PG8_LDA(At, 0, 1); PG8_STAGE(PG8_SB(0, 0), b2, voffB); PG8_STAGE(PG8_SB(0, 1), b2 + hstep, voffB);
            if constexpr (Sched::GATHER) PG8_STAGE_G(PG8_SA(0, 0), ko2, un ? nG[0][0] : cG[0][0], un ? nG[0][1] : cG[0][1]); else PG8_STAGE(PG8_SA(0, 0), a2, voffA);
            PG8_WAIT_V(8); PG8_WAIT_L(0); PG8_BAR; PG8_MMA(1, 0, At, B0); PG8_MMA(1, 1, At, B1); PG8_BAR; PG8_SCHED;
            PG8_LDB(B0, 1, 0); PG8_LDB(B1, 1, 1); PG8_SCHED; PG8_LDA(At, 1, 0);
            if constexpr (Sched::GATHER) PG8_STAGE_G(PG8_SA(0, 1), ko2, un ? nG[1][0] : cG[1][0], un ? nG[1][1] : cG[1][1]); else PG8_STAGE(PG8_SA(0, 1), a2 + hstep, voffA);
            PG8_WAIT_V(8); PG8_WAIT_L(0); PG8_BAR; PG8_MMA(0, 0, At, B0); PG8_MMA(0, 1, At, B1); PG8_BAR; PG8_SCHED;
            PG8_LDA(At, 1, 1); PG8_STAGE(PG8_SB(1, 0), b3, voffB); PG8_STAGE(PG8_SB(1, 1), b3 + hstep, voffB);
            if constexpr (Sched::GATHER) PG8_STAGE_G(PG8_SA(1, 0), ko3, un ? nG[0][0] : cG[0][0], un ? nG[0][1] : cG[0][1]); else PG8_STAGE(PG8_SA(1, 0), a3, voffA);
            PG8_WAIT_V(8); PG8_WAIT_L(0); PG8_BAR; PG8_MMA(1, 0, At, B0); PG8_MMA(1, 1, At, B1); PG8_BAR; PG8_SCHED;
        }
        if (wr == 0) PG8_BAR;
        unsigned xG[2][2];
        if constexpr (Sched::GATHER) { Unit n2; if (S.next(ui + 2, n2)) PG8_GIDX(xG, n2); else PG8_GIDX(xG, cur); }
        E(acc, cur, wr, wc, fr, fq); S.done(cur);
        if constexpr (Sched::GATHER) { PG8_GOFF(xG);
#pragma unroll
            for (int h_ = 0; h_ < 2; ++h_)
#pragma unroll
                for (int i_ = 0; i_ < 2; ++i_) { cG[h_][i_] = nG[h_][i_]; nG[h_][i_] = xG[h_][i_]; } }
        if (!has_next) break;
#pragma unroll
        for (int a = 0; a < 2; ++a)
#pragma unroll
            for (int b = 0; b < 2; ++b)
#pragma unroll
                for (int m = 0; m < 4; ++m)
#pragma unroll
                    for (int n = 0; n < 2; ++n) acc[a][b][m][n] = (f32x4){0.f, 0.f, 0.f, 0.f};
        cur = nxt; cA = nA; cB = nB; ++ui;
        if (wr == 1) PG8_BAR;
    }
    PG8_WAIT_V(0);
    PG8_BAR;
#undef PG8_SA
#undef PG8_SB
#undef PG8_STAGE
#undef PG8_GIDX
#undef PG8_GOFF
#undef PG8_STAGE_G
#undef PG8_LDA
#undef PG8_LDB
#undef PG8_MMA
#undef PG8_WAIT_V
#undef PG8_WAIT_L
#undef PG8_BAR
#undef PG8_SCHED
}

struct EpiProj {
    static constexpr bool PERM = true;
    bf16_t *pa, *pq; const float* rstd;
    __device__ __forceinline__ void operator()(const f32x4 (&acc)[2][2][4][2], const Unit& u, int wr, int wc, int fr, int fq) const {
        const int row0 = u.pm * BM + wr * 64 + fr; int colt = u.pn * BM; bf16_t* base = pa;
        if (colt >= 1536) { base = pq; colt -= 1536; }
        const int col0 = colt + wc * 32 + 8 * fq;
        const __amdgpu_buffer_rsrc_t rs = __builtin_amdgcn_make_buffer_rsrc((void*)base, 0, MR * 1536 * 2, 0x00020000);
#pragma unroll
        for (int ai = 0; ai < 2; ++ai)
#pragma unroll
            for (int m = 0; m < 4; ++m) { const int row = row0 + ai * HALF + m * 16; const float sc = rstd[row];
                const int orow = row + TREAL + (row >= SEQ ? (LP - SEQ) : 0);
                const int boff = (orow * 1536 + col0) * 2;
#pragma unroll
                for (int bj = 0; bj < 2; ++bj) { const f32x4 v0 = acc[ai][bj][m][0] * sc, v1 = acc[ai][bj][m][1] * sc;
                    u32x4 w; w.x = cvt_pk_bf16(v0[0], v0[1]); w.y = cvt_pk_bf16(v0[2], v0[3]); w.z = cvt_pk_bf16(v1[0], v1[1]); w.w = cvt_pk_bf16(v1[2], v1[3]);
                    __builtin_amdgcn_raw_buffer_store_b128(w, rs, boff + bj * HALF * 2, 0, 16); } }
    }
};
struct EpiZ {
    static constexpr bool PERM = true;
    bf16_t* pz; const float* rstd;
    __device__ __forceinline__ void operator()(const f32x4 (&acc)[2][2][4][2], const Unit& u, int wr, int wc, int fr, int fq) const {
        const int row0 = u.pm * BM + wr * 64 + fr, col0 = u.pn * BM + wc * 32 + 8 * fq;
#pragma unroll
        for (int ai = 0; ai < 2; ++ai)
#pragma unroll
            for (int m = 0; m < 4; ++m) { const int row = row0 + ai * HALF + m * 16; const float sc = rstd[row];
                bf16_t* rowp = pz + (size_t)row * 512 + col0;
#pragma unroll
                for (int bj = 0; bj < 2; ++bj) { const f32x4 v0 = acc[ai][bj][m][0] * sc, v1 = acc[ai][bj][m][1] * sc;
                    u32x4 w; w.x = cvt_pk_bf16(v0[0], v0[1]); w.y = cvt_pk_bf16(v0[2], v0[3]); w.z = cvt_pk_bf16(v1[0], v1[1]); w.w = cvt_pk_bf16(v1[2], v1[3]);
                    *(u32x4*)(rowp + bj * HALF) = w; } }
    }
};
struct ZOrder {
    static constexpr bool GATHER = false;
    int j, nw;
    __device__ bool next(int i, Unit& o) const { const int L = j + i * nw; if (L >= 128) return false;
        o.pm = L >> 1; o.pn = L & 1; o.aoff = (unsigned)(L >> 1) * (256u * DM * 2u); o.boff = (unsigned)(12 + (L & 1)) * (256u * DM * 2u); return true; }
    __device__ __forceinline__ void a_ready(const Unit&) const {}
    __device__ __forceinline__ void done(const Unit&) const {}
};
struct EpiRes {
    static constexpr bool PERM = true;
    const bf16_t* xb; bf16_t* h1;
    __device__ __forceinline__ void operator()(const f32x4 (&acc)[2][2][4][2], const Unit& u, int wr, int wc, int fr, int fq) const {
        const int row0 = u.pm * BM + wr * 64 + fr, col0 = u.pn * BM + wc * 32 + 8 * fq;
        u32x4 xr[2][4][2];
#pragma unroll
        for (int ai = 0; ai < 2; ++ai)
#pragma unroll
            for (int m = 0; m < 4; ++m)
#pragma unroll
                for (int bj = 0; bj < 2; ++bj) xr[ai][m][bj] = __builtin_nontemporal_load((const u32x4*)(xb + (size_t)(row0 + ai * HALF + m * 16) * DM + col0 + bj * HALF));
#pragma unroll
        for (int ai = 0; ai < 2; ++ai)
#pragma unroll
            for (int m = 0; m < 4; ++m) { const size_t off = (size_t)(row0 + ai * HALF + m * 16) * DM + col0;
#pragma unroll
                for (int bj = 0; bj < 2; ++bj) { const u32x4 x4 = xr[ai][m][bj];
                    const f32x4 v0 = (f32x4){bf_lo(x4.x), bf_hi(x4.x), bf_lo(x4.y), bf_hi(x4.y)} + acc[ai][bj][m][0], v1 = (f32x4){bf_lo(x4.z), bf_hi(x4.z), bf_lo(x4.w), bf_hi(x4.w)} + acc[ai][bj][m][1];
                    u32x4 w; w.x = cvt_pk_bf16(v0[0], v0[1]); w.y = cvt_pk_bf16(v0[2], v0[3]); w.z = cvt_pk_bf16(v1[0], v1[1]); w.w = cvt_pk_bf16(v1[2], v1[3]);
                    *(u32x4*)(h1 + off + bj * HALF) = w; } }
    }
};
struct EpiGU {
    static constexpr bool PERM = true;
    bf16_t* hid; const float* rsc; const LAS int* tvalid;
    __device__ __forceinline__ void operator()(const f32x4 (&acc)[2][2][4][2], const Unit& u, int wr, int wc, int fr, int fq) const {
        const __amdgpu_buffer_rsrc_t rs = __builtin_amdgcn_make_buffer_rsrc((void*)hid, 0, ROWS_CAP * DEXP * 2, 0x00020000);
        const int row0 = u.pm * BM + wr * 64 + fr, col0 = u.pn * HALF + wc * 32 + 8 * fq, nvalid = tvalid[u.pm] + u.pm * BM;
#pragma unroll
        for (int ai = 0; ai < 2; ++ai)
#pragma unroll
            for (int m = 0; m < 4; ++m) { const int row = row0 + ai * HALF + m * 16; if (row >= nvalid) continue; const float sc = rsc[row];
                float h[8];
#pragma unroll
                for (int n = 0; n < 2; ++n)
#pragma unroll
                    for (int i = 0; i < 4; ++i) { const float gt = acc[ai][0][m][n][i] * sc, up = acc[ai][1][m][n][i] * sc; h[4 * n + i] = silu_f(gt) * up; }
                u32x4 w; w.x = cvt_pk_bf16(h[0], h[1]); w.y = cvt_pk_bf16(h[2], h[3]); w.z = cvt_pk_bf16(h[4], h[5]); w.w = cvt_pk_bf16(h[6], h[7]);
                __builtin_amdgcn_raw_buffer_store_b128(w, rs, (row * DEXP + col0) * 2, 0, 16); }
    }
};
struct EpiBf16 {
    static constexpr bool PERM = true;
    bf16_t* O; int ldc; const LAS int* tvalid;
    __device__ __forceinline__ void operator()(const f32x4 (&acc)[2][2][4][2], const Unit& u, int wr, int wc, int fr, int fq) const {
        const int row0 = u.pm * BM + wr * 64 + fr, col0 = u.pn * BM + wc * 32 + 8 * fq, nvalid = tvalid[u.pm] + u.pm * BM;
#pragma unroll
        for (int ai = 0; ai < 2; ++ai)
#pragma unroll
            for (int m = 0; m < 4; ++m) { if (row0 + ai * HALF + m * 16 >= nvalid) continue; bf16_t* rowp = O + (size_t)(row0 + ai * HALF + m * 16) * ldc + col0;
#pragma unroll
                for (int bj = 0; bj < 2; ++bj) { const f32x4 v0 = acc[ai][bj][m][0], v1 = acc[ai][bj][m][1];
                    u32x4 w; w.x = cvt_pk_bf16(v0[0], v0[1]); w.y = cvt_pk_bf16(v0[2], v0[3]); w.z = cvt_pk_bf16(v1[0], v1[1]); w.w = cvt_pk_bf16(v1[2], v1[3]);
                    *(u32x4*)(rowp + bj * HALF) = w; } }
    }
};
}

struct Args { const float* in[20]; float* out; unsigned char* ws; int ph_lo, ph_hi; };
enum { I_X = 0, I_META, I_MIXNW, I_WIN, I_CMW, I_CMNW, I_QKVCW, I_ALOG, I_DTB, I_GDNNW, I_WOUT, I_FFNNW, I_WGRP, I_BGRP, I_WRT, I_BRT, I_WG, I_WU, I_WD, I_FINNW };

struct Frame {
    LAS unsigned char* lds;
    unsigned char* ws; unsigned char* dob;
    int tid, lane, wave, G, vcu;
};

constexpr int TR_SCR = 64 * 65 * 4;
template <bool NT_STORE> __device__ __forceinline__ void transpose_tile64(const float* W, int ldn, int Kout, bf16_t* WT, const float* kscale, LAS float* scr, int k0, int n0, int outrow0, int lane) {
    const int kr = lane >> 4, c4 = lane & 15;
    f32x4 v[16];
#pragma unroll
    for (int i = 0; i < 16; ++i) v[i] = __builtin_nontemporal_load((const f32x4*)(W + (size_t)(k0 + 4 * i + kr) * ldn + n0 + 4 * c4));
#pragma unroll
    for (int i = 0; i < 16; ++i) { LAS float* d = scr + (4 * i + kr) * 65 + 4 * c4; d[0] = v[i][0]; d[1] = v[i][1]; d[2] = v[i][2]; d[3] = v[i][3]; }
    LDS_WAIT(); asm volatile("" ::: "memory");
    const int kc = lane & 7, nr = lane >> 3;
    float sc[8];
#pragma unroll
    for (int i = 0; i < 8; ++i) sc[i] = kscale ? kscale[k0 + 8 * kc + i] : 1.f;
#pragma unroll
    for (int j = 0; j < 8; ++j) { const int n = nr + 8 * j; const LAS float* t = scr + (8 * kc) * 65 + n;
        u32x4 o; o.x = cvt_pk_bf16(t[0] * sc[0], t[65] * sc[1]); o.y = cvt_pk_bf16(t[130] * sc[2], t[195] * sc[3]); o.z = cvt_pk_bf16(t[260] * sc[4], t[325] * sc[5]); o.w = cvt_pk_bf16(t[390] * sc[6], t[455] * sc[7]);
        if constexpr (NT_STORE) __builtin_nontemporal_store(o, (u32x4*)(WT + (size_t)(outrow0 + n) * Kout + k0 + 8 * kc));
        else *(u32x4*)(WT + (size_t)(outrow0 + n) * Kout + k0 + 8 * kc) = o; }
    LDS_WAIT(); asm volatile("" ::: "memory");
}

__device__ __forceinline__ void p0_prologue(Frame& F, const Args& a) {
    const int gw = F.vcu * 8 + F.wave, NGW = F.G * 8;
    LAS float* scr = (LAS float*)(F.lds + F.wave * TR_SCR);
    LAS float* wab = (LAS float*)(F.lds);
    const float* w_in = a.in[I_WIN]; const float* mixnw = a.in[I_MIXNW];
    bf16_t* WinT = (bf16_t*)(F.ws + WS_WIN); bf16_t* WoutT = (bf16_t*)(F.ws + WS_WOUT);
    constexpr int I_IN = 16 * 56, I_OUT = 16 * 16, I_WR = 32 * 3 * 2;
    for (int it = gw; it < I_IN + I_OUT + I_WR; it += NGW) {
        int r = it;
        if (r < I_IN) { transpose_tile64<false>(w_in, PROJ_LD, DM, WinT, mixnw, scr, 64 * (r / 56), 64 * (r % 56), 64 * (r % 56), F.lane); continue; } r -= I_IN;
        if (r < I_OUT) { transpose_tile64<false>(a.in[I_WOUT], DM, DM, WoutT, nullptr, scr, 64 * (r / 16), 64 * (r % 16), 64 * (r % 16), F.lane); continue; } r -= I_OUT;
        {
            const int ks = r / 6, nt = (r % 6) >> 1, hl = r & 1, j = F.lane & 15, q = F.lane >> 4, c = 16 * nt + j; unsigned pk[4];
#pragma unroll
            for (int jp = 0; jp < 4; ++jp) { float wv[2];
#pragma unroll
                for (int t = 0; t < 2; ++t) { const int k = 32 * ks + 8 * q + 2 * jp + t; float w = 0.f;
                    if (c < 4) w = a.in[I_WGRP][k * 4 + c]; else if (c < 36) w = a.in[I_WRT][k * 32 + (c - 4)];
                    w *= a.in[I_FFNNW][k];
                    const float hi = bf_lo(cvt_pk_bf16(w, 0.f) & 0xffffu); wv[t] = hl ? (w - hi) : hi; }
                pk[jp] = cvt_pk_bf16(wv[0], wv[1]); }
            ((u32x4*)(F.ws + WS_WRF))[(size_t)r * 64 + F.lane] = (u32x4){pk[0], pk[1], pk[2], pk[3]};
        }
    }
    __syncthreads();
    if (F.vcu < 192) {
        const int n0 = 16 * F.vcu, l15 = F.lane & 15, q = F.lane >> 4, kb = 128 * F.wave;
        const float* mrow = a.in[I_META] + (size_t)l15 * DM + kb + q; const float* wcol = w_in + (size_t)(kb + q) * PROJ_LD + n0 + l15;
        float av[32], bv[32];
#pragma unroll
        for (int s4 = 0; s4 < 32; ++s4) { av[s4] = mrow[4 * s4]; bv[s4] = wcol[(size_t)(4 * s4) * PROJ_LD] * mixnw[kb + 4 * s4 + q]; }
        f32x4 acc = (f32x4){0.f, 0.f, 0.f, 0.f}; float ssq = 0.f;
#pragma unroll
        for (int s4 = 0; s4 < 32; ++s4) { ssq += av[s4] * av[s4]; acc = __builtin_amdgcn_mfma_f32_16x16x4f32(av[s4], bv[s4], acc, 0, 0, 0); }
        ssq += __shfl_xor(ssq, 16); ssq += __shfl_xor(ssq, 32);
        LAS float* red = (LAS float*)(F.lds);
#pragma unroll
        for (int rr = 0; rr < 4; ++rr) red[(F.wave * 16 + 4 * q + rr) * 17 + l15] = acc[rr];
        if (q == 0) red[8 * 16 * 17 + F.wave * 16 + l15] = ssq;
        __syncthreads();
        if (F.tid < 256) { const int i = F.tid >> 4, j = F.tid & 15; float v = 0.f, sq = 0.f;
#pragma unroll
            for (int w = 0; w < 8; ++w) { v += red[(w * 16 + i) * 17 + j]; sq += red[8 * 16 * 17 + w * 16 + i]; }
            v *= rsqrtf(sq * (1.f / DM) + EPS);
            bf16_t* dst = (n0 < 1536 ? (bf16_t*)(F.ws + WS_PA) + n0 : (bf16_t*)(F.ws + WS_PQ) + (n0 - 1536)) + j;
            const bf16_t hb = (bf16_t)(cvt_pk_bf16(v, 0.f) & 0xffffu);
            dst[(size_t)(TPAD + i) * 1536] = hb; dst[(size_t)(LP + TPAD + i) * 1536] = hb; }
        __syncthreads();
    }
    for (int i = F.tid; i < 8 * 1024; i += 512) { const int k = i >> 3, c = i & 7; wab[c * 1024 + k] = w_in[(size_t)k * PROJ_LD + NPROJ + c] * mixnw[k]; }
    __syncthreads();
    bf16_t* xb = (bf16_t*)(F.ws + WS_XB); float* rstd1 = (float*)(F.ws + WS_RSTD1); float* gb = (float*)(F.ws + WS_GB);
#define P0_LOAD_ROW(rr, dst) do { const int b_ = (rr) / LP, t_ = (rr) % LP; \
        if (t_ >= TPAD) { const float* src_ = t_ < TREAL ? a.in[I_META] + (size_t)(t_ - TPAD) * DM : a.in[I_X] + ((size_t)b_ * SEQ + (t_ - TREAL)) * DM; \
            _Pragma("unroll") for (int j = 0; j < 4; ++j) dst[j] = __builtin_nontemporal_load((const f32x4*)src_ + 64 * j + F.lane); } \
        else { _Pragma("unroll") for (int j = 0; j < 4; ++j) dst[j] = (f32x4){0.f, 0.f, 0.f, 0.f}; } } while (0)
    f32x4 vnx[4];
    if (gw < MR) P0_LOAD_ROW(gw, vnx);
    for (int r = gw; r < MR; r += NGW) {
        const int t = r % LP;
        f32x4 v[4];
#pragma unroll
        for (int j = 0; j < 4; ++j) v[j] = vnx[j];
        if (r + NGW < MR) P0_LOAD_ROW(r + NGW, vnx);
        float ss = 0.f;
#pragma unroll
        for (int j = 0; j < 4; ++j) ss += (v[j][0] * v[j][0] + v[j][1] * v[j][1]) + (v[j][2] * v[j][2] + v[j][3] * v[j][3]);
        ss = wave_sum(ss);
        const float rstd = rsqrtf(ss * (1.f / DM) + EPS);
        if (t >= TREAL) {
            const int m = (r / LP) * SEQ + (t - TREAL);
            u32x2* o8 = (u32x2*)(xb + (size_t)m * DM);
#pragma unroll
            for (int j = 0; j < 4; ++j) { u32x2 w; w.x = cvt_pk_bf16(v[j][0], v[j][1]); w.y = cvt_pk_bf16(v[j][2], v[j][3]); o8[64 * j + F.lane] = w; }
            if (F.lane == 0) rstd1[m] = rstd;
        } else if (t < TPAD) {
            u32x4* za = (u32x4*)((bf16_t*)(F.ws + WS_PA) + (size_t)r * 1536); u32x4* zq = (u32x4*)((bf16_t*)(F.ws + WS_PQ) + (size_t)r * 1536);
#pragma unroll
            for (int j = 0; j < 3; ++j) { za[64 * j + F.lane] = (u32x4){0u, 0u, 0u, 0u}; zq[64 * j + F.lane] = (u32x4){0u, 0u, 0u, 0u}; }
        }
        float ab[8];
#pragma unroll
        for (int c = 0; c < 8; ++c) { float s = 0.f;
#pragma unroll
            for (int j = 0; j < 4; ++j) { const f32x4 w = *(const LAS f32x4*)(wab + c * 1024 + 256 * j + 4 * F.lane); s += (v[j][0] * w[0] + v[j][1] * w[1]) + (v[j][2] * w[2] + v[j][3] * w[3]); }
            ab[c] = wave_sum(s); }
        if (F.lane < 4) { const int h = F.lane;
            float av = ab[0], bv = ab[4];
            if (h == 1) { av = ab[1]; bv = ab[5]; } else if (h == 2) { av = ab[2]; bv = ab[6]; } else if (h == 3) { av = ab[3]; bv = ab[7]; }
            av *= rstd; bv *= rstd;
            const float z = av + a.in[I_DTB][h];
            const float sp = fmaxf(z, 0.f) + log1pf(expf(-fabsf(z)));
            float g = -expf(a.in[I_ALOG][h]) * sp, be = 1.f / (1.f + expf(-bv));
            if (t < TPAD) { g = 0.f; be = 0.f; }
            gb[(size_t)r * 8 + h] = g; gb[(size_t)r * 8 + 4 + h] = be; }
    }
#undef P0_LOAD_ROW
}

__device__ __forceinline__ void unpack8(const u32x4 w, float (&f)[8]) { f[0] = bf_lo(w.x); f[1] = bf_hi(w.x); f[2] = bf_lo(w.y); f[3] = bf_hi(w.y); f[4] = bf_lo(w.z); f[5] = bf_hi(w.z); f[6] = bf_lo(w.w); f[7] = bf_hi(w.w); }
__device__ __forceinline__ void p2_mixer_a(Frame& F, const Args& a) {
    if (F.G > 16 && F.vcu < 8) return;
    const int skip = F.G > 16 ? 8 : 0;
    const int gw = (F.vcu - skip) * 8 + F.wave, NGW = (F.G - skip) * 8;
    const bf16_t* PA = (const bf16_t*)(F.ws + WS_PA); bf16_t* YC = (bf16_t*)(F.ws + WS_YCAT);
    const int c0 = 8 * F.lane;
    float w0[8], w1[8], w2[8], nw[8];
#pragma unroll
    for (int i = 0; i < 8; ++i) { w0[i] = a.in[I_CMW][c0 + i]; w1[i] = a.in[I_CMW][512 + c0 + i]; w2[i] = a.in[I_CMW][1024 + c0 + i]; nw[i] = a.in[I_CMNW][c0 + i]; }
    for (int uu = gw; uu < MT / 8; uu += NGW) {
        const int b = uu / (SEQ / 8), s0 = (uu % (SEQ / 8)) * 8;
        const size_t r0 = (size_t)b * LP + s0 + TREAL;
        u32x4 gcr[10], uvr[10], gbr[8];
#pragma unroll
        for (int w = 0; w < 10; ++w) { gcr[w] = __builtin_nontemporal_load((const u32x4*)(PA + (r0 - 2 + w) * 1536 + 512 + c0)); uvr[w] = __builtin_nontemporal_load((const u32x4*)(PA + (r0 - 2 + w) * 1536 + 1024 + c0)); }
#pragma unroll
        for (int w = 0; w < 8; ++w) gbr[w] = __builtin_nontemporal_load((const u32x4*)(PA + (r0 + w) * 1536 + c0));
        float p2[8], p1[8];
        { float gc[8], uv[8]; unpack8(gcr[0], gc); unpack8(uvr[0], uv);
#pragma unroll
          for (int i = 0; i < 8; ++i) p2[i] = gc[i] * uv[i];
          unpack8(gcr[1], gc); unpack8(uvr[1], uv);
#pragma unroll
          for (int i = 0; i < 8; ++i) p1[i] = gc[i] * uv[i]; }
#pragma unroll
        for (int rr = 0; rr < 8; ++rr) {
            float gc[8], uv[8], gbv[8], y[8];
            unpack8(gbr[rr], gbv); unpack8(gcr[rr + 2], gc); unpack8(uvr[rr + 2], uv);
            float ss = 0.f;
#pragma unroll
            for (int i = 0; i < 8; ++i) { const float p = gc[i] * uv[i]; y[i] = gbv[i] * (w0[i] * p2[i] + w1[i] * p1[i] + w2[i] * p); p2[i] = p1[i]; p1[i] = p; ss += y[i] * y[i]; }
            ss += __shfl_xor(ss, 1); ss += __shfl_xor(ss, 2); ss += __shfl_xor(ss, 4);
            const float rs = rsqrtf(ss * (1.f / 64.f) + EPS);
            u32x4 w; w.x = cvt_pk_bf16(y[0] * rs * nw[0], y[1] * rs * nw[1]); w.y = cvt_pk_bf16(y[2] * rs * nw[2], y[3] * rs * nw[3]);
            w.z = cvt_pk_bf16(y[4] * rs * nw[4], y[5] * rs * nw[5]); w.w = cvt_pk_bf16(y[6] * rs * nw[6], y[7] * rs * nw[7]);
            *(u32x4*)(YC + ((size_t)b * SEQ + s0 + rr) * DM + c0) = w;
        }
    }
}

constexpr int P3_Q16 = 0, P3_K16 = 16384, P3_RT = 32768, P3_T16 = 65536, P3_LM = 73728, P3_TF = 91136, P3_XS = 108544, P3_GC = 113152, P3_CW = 114176;
static_assert(P3_CW + 4 * 1536 * 4 <= LDSCTL_OFF, "P3 LDS map");
__device__ __forceinline__ int p3_sw(int row, int chunk) { return row * 256 + ((chunk ^ (row & 15)) << 4); }
__device__ __forceinline__ int p3_sw64(int row, int chunk) { return row * 128 + ((chunk ^ ((row >> 1) & 7)) << 4); }
__device__ __forceinline__ float silu_fast(float x) { return x * __builtin_amdgcn_rcpf(1.f + __expf(-x)); }
__device__ __forceinline__ void mm16(f32x4& acc, const LAS float* Ab, int lda, const LAS float* Bb, int ldb, int l15, int q) {
#pragma unroll
    for (int s4 = 0; s4 < 4; ++s4) acc = __builtin_amdgcn_mfma_f32_16x16x4f32(Ab[l15 * lda + 4 * s4 + q], Bb[(4 * s4 + q) * ldb + l15], acc, 0, 0, 0);
}
__device__ __forceinline__ void p3_prefetch(Frame& F, const Args& a, int unit, float& pg, float& pbe, u32x4 (&xp)[11]) {
    const int bh = unit / NCHUNK, n = unit % NCHUNK, b = bh >> 2, h = bh & 3, t0 = 64 * n;
    const size_t rbase = (size_t)b * LP + t0;
    const float* gb = (const float*)(F.ws + WS_GB);
    if (F.tid < 64) { pg = gb[(rbase + F.tid) * 8 + h]; pbe = gb[(rbase + F.tid) * 8 + 4 + h]; }
    if (F.tid < 384) {
        const int part = F.tid >> 7, rb = (F.tid >> 4) & 7, ch = F.tid & 15, dk0 = ch * 8;
        const int col = part * 512 + h * 128 + dk0;
        const bf16_t* PQ = (const bf16_t*)(F.ws + WS_PQ);
#pragma unroll
        for (int w = 0; w < 11; ++w) { const int tt = t0 + 8 * rb - 3 + w;
            if (tt >= 0) xp[w] = __builtin_nontemporal_load((const u32x4*)(PQ + ((size_t)b * LP + tt) * 1536 + col)); else xp[w] = (u32x4){0u, 0u, 0u, 0u}; }
    }
}
__device__ __forceinline__ void p3_phase(Frame& F, const Args& a) {
  float pg = 0.f, pbe = 0.f; u32x4 xp[11];
  int unit = F.vcu;
  if (unit < NUNIT_GDN) p3_prefetch(F, a, unit, pg, pbe, xp);
  { LAS float* cw0 = (LAS float*)(F.lds + P3_CW);
    for (int i = F.tid; i < 4 * 1536; i += 512) cw0[i] = a.in[I_QKVCW][i]; }
  __syncthreads();
  for (; unit < NUNIT_GDN; unit += F.G) {
    int vzu; asm volatile("v_mov_b32 %0, 0" : "=v"(vzu));
    const int tid_o = F.tid + vzu, lane_o = tid_o & 63, l15 = lane_o & 15, q = lane_o >> 4;
    LAS unsigned char* L = F.lds + vzu;
    LAS float* gcs = (LAS float*)(L + P3_GC);
    LAS float* Lm = (LAS float*)(L + P3_LM);
    LAS float* Tf = (LAS float*)(L + P3_TF);
    LAS float* Xs = (LAS float*)(L + P3_XS);
    LAS float* cwl = (LAS float*)(L + P3_CW);
    const int bh = unit / NCHUNK, n = unit % NCHUNK, h = bh & 3, t0 = 64 * n;
    unsigned char* gW = F.dob + DO_W + (size_t)unit * 16384; unsigned char* gU = F.dob + DO_U + (size_t)unit * 16384; unsigned char* gQG = F.dob + DO_QG + (size_t)unit * 16384;
    unsigned char* gKD = F.ws + WS_KD + (size_t)unit * 16384; unsigned char* gIN = F.ws + WS_IN + (size_t)unit * 8192;
    if (F.tid < 64) {
        float g = pg; const float be = pbe;
#pragma unroll
        for (int o = 1; o < 64; o <<= 1) { const float t = __shfl_up(g, o); if (F.lane >= o) g += t; }
        const float gl = __shfl(g, 63);
        gcs[F.tid] = g; gcs[64 + F.tid] = be; gcs[128 + F.tid] = __expf(g); gcs[192 + F.tid] = __expf(gl - g);
        if (F.tid == 63) ((float*)(F.ws + WS_ALAST))[unit] = __expf(g);
    }
    __syncthreads();
    if (F.tid < 384) {
        const int part = F.wave >> 1, rb = (tid_o >> 4) & 7, ch = tid_o & 15, dk0 = ch * 8;
        const int col = part * 512 + h * 128 + dk0;
        float cw[4][8];
#pragma unroll
        for (int j = 0; j < 4; ++j) { const f32x4 c0 = *(const LAS f32x4*)(cwl + j * 1536 + col), c1 = *(const LAS f32x4*)(cwl + j * 1536 + col + 4);
            cw[j][0] = c0[0]; cw[j][1] = c0[1]; cw[j][2] = c0[2]; cw[j][3] = c0[3]; cw[j][4] = c1[0]; cw[j][5] = c1[1]; cw[j][6] = c1[2]; cw[j][7] = c1[3]; }
        float xw[4][8];
        unpack8(xp[0], xw[0]); unpack8(xp[1], xw[1]); unpack8(xp[2], xw[2]);
        unsigned kdp[4][8], rtp[4][8]; float kde[8], rte[8];
        unsigned char* qgb; { const int mt = rb >> 1, ks = dk0 >> 5, r32 = dk0 & 31, half = r32 >> 4, qq = (r32 & 15) >> 2;
            qgb = gQG + ((size_t)((mt * 4 + ks) * 64 + 8 * (rb & 1)) << 4) + half * 8 + (qq << 8); }
#pragma unroll
        for (int rr = 0; rr < 8; ++rr) {
            const int row = 8 * rb + rr; const bool valid = (t0 + row) >= TPAD;
            float o[8]; float ss = 0.f;
            unpack8(xp[rr + 3], xw[(rr + 3) & 3]);
#pragma unroll
            for (int i = 0; i < 8; ++i) { const float c = (cw[0][i] * xw[rr & 3][i] + cw[1][i] * xw[(rr + 1) & 3][i]) + (cw[2][i] * xw[(rr + 2) & 3][i] + cw[3][i] * xw[(rr + 3) & 3][i]); o[i] = silu_fast(c); ss += o[i] * o[i]; }
            const float be = gcs[64 + row], eg = gcs[128 + row], ekd = gcs[192 + row];
            if (part < 2) {
                ss += __shfl_xor(ss, 1); ss += __shfl_xor(ss, 2); ss += __shfl_xor(ss, 4); ss += __shfl_xor(ss, 8);
                float rs = rsqrtf(ss + EPS); if (part == 0) rs *= 0.08838834764831845f; if (!valid) rs = 0.f;
#pragma unroll
                for (int i = 0; i < 8; ++i) o[i] *= rs;
                u32x4 w; w.x = cvt_pk_bf16(o[0], o[1]); w.y = cvt_pk_bf16(o[2], o[3]); w.z = cvt_pk_bf16(o[4], o[5]); w.w = cvt_pk_bf16(o[6], o[7]);
                *(LAS u32x4*)(L + (part == 0 ? P3_Q16 : P3_K16) + p3_sw(row, ch)) = w;
                if (part == 0) {
                    u32x2 p0, p1; p0.x = cvt_pk_bf16(o[0] * eg, o[1] * eg); p0.y = cvt_pk_bf16(o[2] * eg, o[3] * eg); p1.x = cvt_pk_bf16(o[4] * eg, o[5] * eg); p1.y = cvt_pk_bf16(o[6] * eg, o[7] * eg);
                    *(u32x2*)(qgb + rr * 16) = p0; *(u32x2*)(qgb + 256 + rr * 16) = p1;
                } else {
                    const float sc = be * eg;
                    if ((rr & 1) == 0) {
#pragma unroll
                        for (int i = 0; i < 8; ++i) { kde[i] = o[i] * ekd; rte[i] = o[i] * sc; }
                    } else {
#pragma unroll
                        for (int i = 0; i < 8; ++i) { kdp[rr >> 1][i] = cvt_pk_bf16(kde[i], o[i] * ekd); rtp[rr >> 1][i] = cvt_pk_bf16(rte[i], o[i] * sc); }
                    }
                }
            } else {
                const float sc = valid ? be : 0.f;
                if ((rr & 1) == 0) {
#pragma unroll
                    for (int i = 0; i < 8; ++i) rte[i] = o[i] * sc;
                } else {
#pragma unroll
                    for (int i = 0; i < 8; ++i) rtp[rr >> 1][i] = cvt_pk_bf16(rte[i], o[i] * sc);
                }
            }
        }
        if (part == 1) {
            const int tb = 8 * rb, ks2 = tb >> 5, r32 = tb & 31, half = r32 >> 4, qq = (r32 & 15) >> 2, dt = ch >> 1;
            unsigned char* kdb = gKD + ((size_t)((dt * 2 + ks2) * 64 + 8 * (ch & 1)) << 4) + half * 8 + (qq << 8);
#pragma unroll
            for (int i = 0; i < 8; ++i) { u32x2 p0, p1; p0.x = kdp[0][i]; p0.y = kdp[1][i]; p1.x = kdp[2][i]; p1.y = kdp[3][i];
                *(u32x2*)(kdb + i * 16) = p0; *(u32x2*)(kdb + 256 + i * 16) = p1; }
        }
        if (part >= 1) {
            const int n0 = (part == 1 ? 128 : 0) + dk0;
#pragma unroll
            for (int i = 0; i < 8; ++i) *(LAS u32x4*)(L + P3_RT + p3_sw64(n0 + i, rb)) = (u32x4){rtp[0][i], rtp[1][i], rtp[2][i], rtp[3][i]};
        }
    }
    __syncthreads();
    {
        const int prod = F.wave >> 2, mt = F.wave & 3;
        bf16x8 af[4];
#pragma unroll
        for (int ks = 0; ks < 4; ++ks) af[ks] = *(const LAS bf16x8*)(L + P3_K16 + p3_sw(16 * mt + l15, 4 * ks + q));
#pragma unroll
        for (int nt = 0; nt < 4; ++nt) {
            f32x4 d = (f32x4){0.f, 0.f, 0.f, 0.f};
#pragma unroll
            for (int ks = 0; ks < 4; ++ks) { const bf16x8 bfr = *(const LAS bf16x8*)(L + (prod == 0 ? P3_K16 : P3_Q16) + p3_sw(16 * nt + l15, 4 * ks + q)); d = __builtin_amdgcn_mfma_f32_16x16x32_bf16(af[ks], bfr, d, 0, 0, 0); }
            const int i = 16 * nt + l15, j0 = 16 * mt + 4 * q; const float gi = gcs[i], bi = gcs[64 + i];
            float v[4];
#pragma unroll
            for (int r = 0; r < 4; ++r) { const int j = j0 + r; const float dec = __expf(fminf(gi - gcs[j], 0.f));
                if (prod == 0) v[r] = (i > j) ? bi * d[r] * dec : 0.f; else v[r] = (i >= j) ? d[r] * dec : 0.f; }
            if (prod == 0) *(LAS f32x4*)(Lm + i * 68 + j0) = (f32x4){v[0], v[1], v[2], v[3]};
            else { u32x2 p; p.x = cvt_pk_bf16(v[0], v[1]); p.y = cvt_pk_bf16(v[2], v[3]);
                *(u32x2*)(gIN + ((size_t)((nt * 2 + (mt >> 1)) * 64 + q * 16 + l15) << 4) + (mt & 1) * 8) = p; }
        }
    }
    { const int un = unit + F.G; if (un < NUNIT_GDN) p3_prefetch(F, a, un, pg, pbe, xp); }
    __syncthreads();
    if (F.wave < 4) {
        const int bb = F.wave; int vz; asm volatile("v_mov_b32 %0, 0" : "=v"(vz));
        const LAS float* Lb = Lm + (16 * bb) * 68 + 16 * bb + vz;
        float av[16]; av[0] = 0.f;
#pragma unroll
        for (int i = 1; i < 16; ++i) { float sacc = -Lb[i * 68 + l15];
#pragma unroll
            for (int jb = 0; jb < (i + 3) / 4; ++jb) { const f32x4 lv = *(const LAS f32x4*)(Lb + i * 68 + 4 * jb);
                if (4 * jb >= 1) sacc -= lv[0] * av[4 * jb]; if (4 * jb + 1 < i) sacc -= lv[1] * av[4 * jb + 1]; if (4 * jb + 2 < i) sacc -= lv[2] * av[4 * jb + 2]; if (4 * jb + 3 < i) sacc -= lv[3] * av[4 * jb + 3]; }
            av[i] = sacc; }
        if (q == 0) {
#pragma unroll
            for (int i = 0; i < 16; ++i) Tf[(16 * bb + i) * 68 + 16 * bb + l15] = av[i] + (i == l15 ? 1.f : 0.f); }
    }
    __syncthreads();
    if (F.wave < 2) {
        const int lo = 2 * F.wave, hi = lo + 1; LAS float* Xp = Xs + F.wave * 16 * 36;
        f32x4 acc = (f32x4){0.f, 0.f, 0.f, 0.f};
        mm16(acc, Lm + (16 * hi) * 68 + 16 * lo, 68, Tf + (16 * lo) * 68 + 16 * lo, 68, l15, q);
#pragma unroll
        for (int r = 0; r < 4; ++r) Xp[(4 * q + r) * 36 + l15] = acc[r];
        LDS_WAIT(); asm volatile("" ::: "memory");
        acc = (f32x4){0.f, 0.f, 0.f, 0.f};
        mm16(acc, Tf + (16 * hi) * 68 + 16 * hi, 68, Xp, 36, l15, q);
#pragma unroll
        for (int r = 0; r < 4; ++r) Tf[(16 * hi + 4 * q + r) * 68 + 16 * lo + l15] = -acc[r];
    }
    __syncthreads();
    if (F.wave < 4) {
        const int bi = F.wave >> 1, bj = F.wave & 1;
        f32x4 acc = (f32x4){0.f, 0.f, 0.f, 0.f};
        if (bj == 0) mm16(acc, Lm + (16 * (2 + bi)) * 68, 68, Tf, 68, l15, q);
        mm16(acc, Lm + (16 * (2 + bi)) * 68 + 16, 68, Tf + 16 * 68 + 16 * bj, 68, l15, q);
#pragma unroll
        for (int r = 0; r < 4; ++r) Xs[(16 * bi + 4 * q + r) * 36 + 16 * bj + l15] = acc[r];
    }
    __syncthreads();
    if (F.wave < 4) {
        const int bi = F.wave >> 1, bj = F.wave & 1;
        f32x4 acc = (f32x4){0.f, 0.f, 0.f, 0.f};
        mm16(acc, Tf + (16 * (2 + bi)) * 68 + 32, 68, Xs + 16 * bj, 36, l15, q);
        if (bi == 1) mm16(acc, Tf + 48 * 68 + 48, 68, Xs + 16 * 36 + 16 * bj, 36, l15, q);
#pragma unroll
        for (int r = 0; r < 4; ++r) Tf[(16 * (2 + bi) + 4 * q + r) * 68 + 16 * bj + l15] = -acc[r];
    }
    __syncthreads();
    {
        const int row = tid_o >> 3, chunk = tid_o & 7;
        u32x4 w = (u32x4){0u, 0u, 0u, 0u};
        if ((chunk >> 1) <= (row >> 4)) { const f32x4 t0v = *(const LAS f32x4*)(Tf + row * 68 + 8 * chunk), t1v = *(const LAS f32x4*)(Tf + row * 68 + 8 * chunk + 4);
            w.x = cvt_pk_bf16(t0v[0], t0v[1]); w.y = cvt_pk_bf16(t0v[2], t0v[3]); w.z = cvt_pk_bf16(t1v[0], t1v[1]); w.w = cvt_pk_bf16(t1v[2], t1v[3]); }
        *(LAS u32x4*)(L + P3_T16 + p3_sw64(row, chunk)) = w;
    }
    __syncthreads();
    {
        const int w8 = F.wave;
        bf16x8 rv[2], rk[2];
#pragma unroll
        for (int k2 = 0; k2 < 2; ++k2) { rv[k2] = *(const LAS bf16x8*)(L + P3_RT + p3_sw64(16 * w8 + l15, 4 * k2 + q)); rk[k2] = *(const LAS bf16x8*)(L + P3_RT + p3_sw64(128 + 16 * w8 + l15, 4 * k2 + q)); }
#pragma unroll
        for (int mt = 0; mt < 4; ++mt) {
            bf16x8 tf[2];
#pragma unroll
            for (int k2 = 0; k2 < 2; ++k2) tf[k2] = *(const LAS bf16x8*)(L + P3_T16 + p3_sw64(16 * mt + l15, 4 * k2 + q));
            f32x4 du = (f32x4){0.f, 0.f, 0.f, 0.f}, dw = (f32x4){0.f, 0.f, 0.f, 0.f};
#pragma unroll
            for (int k2 = 0; k2 < 2; ++k2) { du = __builtin_amdgcn_mfma_f32_16x16x32_bf16(tf[k2], rv[k2], du, 0, 0, 0); dw = __builtin_amdgcn_mfma_f32_16x16x32_bf16(rk[k2], tf[k2], dw, 0, 0, 0); }
            u32x2 pu, pw; pu.x = cvt_pk_bf16(du[0], du[1]); pu.y = cvt_pk_bf16(du[2], du[3]); pw.x = cvt_pk_bf16(-dw[0], -dw[1]); pw.y = cvt_pk_bf16(-dw[2], -dw[3]);
            *(u32x2*)(gU + ((size_t)((w8 * 4 + mt) * 64 + lane_o) << 3)) = pu;
            *(u32x2*)(gW + ((size_t)((mt * 4 + (w8 >> 1)) * 64 + lane_o) << 4) + (w8 & 1) * 8) = pw;
        }
    }
    __syncthreads();
  }
}

__device__ __forceinline__ bf16x8 pack8(const f32x4 a, const f32x4 b) {
    u32x4 w; w.x = cvt_pk_bf16(a[0], a[1]); w.y = cvt_pk_bf16(a[2], a[3]); w.z = cvt_pk_bf16(b[0], b[1]); w.w = cvt_pk_bf16(b[2], b[3]);
    return __builtin_bit_cast(bf16x8, w);
}
__device__ __forceinline__ unsigned lds_ld_u32(unsigned addr) { unsigned v; asm volatile("ds_read_b32 %0, %1\n\ts_waitcnt lgkmcnt(0)" : "=v"(v) : "v"(addr) : "memory"); return v; }
__device__ __forceinline__ void lds_st_u32(unsigned addr, unsigned val) { asm volatile("ds_write_b32 %0, %1" :: "v"(addr), "v"(val) : "memory"); }
template <int J> __device__ __forceinline__ void p4_scan_loader(Frame& F, int bh, int s) {
    constexpr int CNT = J < 4 ? 6 : 5;
    const unsigned ctl = (unsigned)(size_t)(F.lds + SC_CTL);
    for (int n = 0; n < NCHUNK; ++n) {
        if (n >= 4) { unsigned sp = 0; while ((int)lds_ld_u32(ctl + 32) < n - 3) { __builtin_amdgcn_s_sleep(1); if (++sp > (1u << 22)) break; } }
        const size_t unit = (size_t)bh * NCHUNK + n;
        const unsigned char* gw = F.dob + DO_W + unit * 16384 + F.lane * 16;
        const unsigned char* gk = F.ws + WS_KD + unit * 16384 + F.lane * 16;
        const unsigned char* gu = F.dob + DO_U + unit * 16384 + (size_t)s * 2048 + F.lane * 16;
        LAS unsigned char* slot = F.lds + (n & 3) * SC_SLOT;
#pragma unroll
        for (int i = 0; i < CNT; ++i) { constexpr int dummy = 0; (void)dummy; const int p = J + 6 * i;
            const unsigned char* src = p < 16 ? gw + p * 1024 : (p < 32 ? gk + (p - 16) * 1024 : gu + (p - 32) * 1024);
            __builtin_amdgcn_global_load_lds((const unsigned*)src, (LAS unsigned*)(slot + p * 1024), 16, 0, 0); }
        if (n >= 2) { if constexpr (CNT == 6) asm volatile("s_waitcnt vmcnt(12)" ::: "memory"); else asm volatile("s_waitcnt vmcnt(10)" ::: "memory");
            lds_st_u32(ctl + 4 * J, (unsigned)(n - 1)); }
    }
    if constexpr (CNT == 6) asm volatile("s_waitcnt vmcnt(6)" ::: "memory"); else asm volatile("s_waitcnt vmcnt(5)" ::: "memory");
    lds_st_u32(ctl + 4 * J, (unsigned)(NCHUNK - 1));
    asm volatile("s_waitcnt vmcnt(0)" ::: "memory"); lds_st_u32(ctl + 4 * J, (unsigned)NCHUNK);
}
__device__ __forceinline__ void lds_poll6_gt(unsigned addr, int n) {
    unsigned sp = 0;
    for (;;) { u32x4 v; u32x2 w; asm volatile("ds_read_b128 %0, %2\n\tds_read_b64 %1, %2 offset:16\n\ts_waitcnt lgkmcnt(0)" : "=&v"(v), "=&v"(w) : "v"(addr) : "memory");
        const bool ok = (int)v.x > n && (int)v.y > n && (int)v.z > n && (int)v.w > n && (int)w.x > n && (int)w.y > n;
        if (ok || ++sp > (1u << 24)) break; }
}
__device__ __forceinline__ void p4_scan_c(Frame& F, int bh, int s) {
    const unsigned ctl = (unsigned)(size_t)(F.lds + SC_CTL);
    f32x4 S[8]; bf16x8 Sb[4];
#pragma unroll
    for (int i = 0; i < 8; ++i) S[i] = (f32x4){0.f, 0.f, 0.f, 0.f};
#pragma unroll
    for (int i = 0; i < 4; ++i) Sb[i] = (bf16x8){0, 0, 0, 0, 0, 0, 0, 0};
    const float* alast = (const float*)(F.ws + WS_ALAST) + bh * NCHUNK;
    const float ala = alast[F.lane], alb = alast[64 + F.lane], alc = alast[128];
    unsigned char* sfr = F.ws + WS_SFR + ((size_t)bh * NCHUNK * 8 + s) * 4096 + F.lane * 16;
    bf16x8 Wr[16]; u32x2 Ur[4];
    lds_poll6_gt(ctl, 0);
#pragma unroll
    for (int f = 0; f < 16; ++f) Wr[f] = *(const LAS bf16x8*)(F.lds + f * 1024 + F.lane * 16);
#pragma unroll
    for (int mt = 0; mt < 4; ++mt) Ur[mt] = *(const LAS u32x2*)(F.lds + 32768 + mt * 512 + F.lane * 8);
    for (int n = 0; n < NCHUNK; ++n) {
        const LAS unsigned char* slot = F.lds + (n & 3) * SC_SLOT + F.lane * 16;
        bf16x8 Kr[16];
#pragma unroll
        for (int f = 0; f < 16; ++f) Kr[f] = *(const LAS bf16x8*)(slot + 16384 + f * 1024);
        f32x4 vn[4];
#pragma unroll
        for (int mt = 0; mt < 4; ++mt) vn[mt] = (f32x4){bf_lo(Ur[mt].x), bf_hi(Ur[mt].x), bf_lo(Ur[mt].y), bf_hi(Ur[mt].y)};
#pragma unroll
        for (int ks = 0; ks < 4; ++ks)
#pragma unroll
            for (int mt = 0; mt < 4; ++mt) vn[mt] = __builtin_amdgcn_mfma_f32_16x16x32_bf16(Wr[mt * 4 + ks], Sb[ks], vn[mt], 0, 0, 0);
#pragma unroll
        for (int ks = 0; ks < 4; ++ks) *(bf16x8*)(sfr + (size_t)n * 32768 + ks * 1024) = Sb[ks];
        bf16x8 Vb[2]; Vb[0] = pack8(vn[0], vn[1]); Vb[1] = pack8(vn[2], vn[3]);
        const float alv = n < 64 ? ala : (n < 128 ? alb : alc);
        const float al = __uint_as_float((unsigned)__builtin_amdgcn_readlane((int)__float_as_uint(alv), n & 63));
#pragma unroll
        for (int dt = 0; dt < 8; ++dt) S[dt] = S[dt] * al;
        lds_st_u32(ctl + 32, (unsigned)(n + 1));
        if (n + 1 < NCHUNK) {
            lds_poll6_gt(ctl, n + 1);
            const LAS unsigned char* nslot = F.lds + ((n + 1) & 3) * SC_SLOT;
#pragma unroll
            for (int f = 0; f < 16; ++f) Wr[f] = *(const LAS bf16x8*)(nslot + f * 1024 + F.lane * 16);
#pragma unroll
            for (int mt = 0; mt < 4; ++mt) Ur[mt] = *(const LAS u32x2*)(nslot + 32768 + mt * 512 + F.lane * 8);
        }
#pragma unroll
        for (int k2 = 0; k2 < 2; ++k2)
#pragma unroll
            for (int dt = 0; dt < 8; ++dt) S[dt] = __builtin_amdgcn_mfma_f32_16x16x32_bf16(Kr[dt * 2 + k2], Vb[k2], S[dt], 0, 0, 0);
#pragma unroll
        for (int ks = 0; ks < 4; ++ks) Sb[ks] = pack8(S[2 * ks], S[2 * ks + 1]);
    }
}

constexpr int PO_OT = 40960;
__device__ __forceinline__ void p4_out_unit(Frame& F, const Args& a, int unit, const float (&nw)[16]) {
    const int bh = unit / NCHUNK, n = unit % NCHUNK, b = bh >> 2, h = bh & 3, s = F.wave, l15 = F.lane & 15, q = F.lane >> 4;
    const unsigned char* gW = F.dob + DO_W + (size_t)unit * 16384; const unsigned char* gQG = F.dob + DO_QG + (size_t)unit * 16384; const unsigned char* gIN = F.ws + WS_IN + (size_t)unit * 8192;
#pragma unroll
    for (int i = 0; i < 5; ++i) { const int p = F.wave + 8 * i;
        const unsigned char* src = (i < 2 ? gW + p * 1024 : (i < 4 ? gQG + (p - 16) * 1024 : gIN + (p - 32) * 1024)) + F.lane * 16;
        __builtin_amdgcn_global_load_lds((const unsigned*)src, (LAS unsigned*)(F.lds + p * 1024), 16, 0, 2); }
    bf16x8 Sb[4]; f32x4 vn[4];
    { const unsigned char* sfr = F.ws + WS_SFR + ((size_t)unit * 8 + s) * 4096 + F.lane * 16;
#pragma unroll
      for (int ks = 0; ks < 4; ++ks) Sb[ks] = __builtin_nontemporal_load((const bf16x8*)(sfr + ks * 1024));
      const unsigned char* gu = F.dob + DO_U + (size_t)unit * 16384 + s * 2048 + F.lane * 8;
#pragma unroll
      for (int mt = 0; mt < 4; ++mt) { const u32x2 u = __builtin_nontemporal_load((const u32x2*)(gu + mt * 512)); vn[mt] = (f32x4){bf_lo(u.x), bf_hi(u.x), bf_lo(u.y), bf_hi(u.y)}; } }
    asm volatile("s_waitcnt vmcnt(0)" ::: "memory");
    __syncthreads();
    const LAS unsigned char* fl = F.lds + F.lane * 16;
#pragma unroll
    for (int ks = 0; ks < 4; ++ks)
#pragma unroll
        for (int mt = 0; mt < 4; ++mt) vn[mt] = __builtin_amdgcn_mfma_f32_16x16x32_bf16(*(const LAS bf16x8*)(fl + (mt * 4 + ks) * 1024), Sb[ks], vn[mt], 0, 0, 0);
    bf16x8 Vb[2]; Vb[0] = pack8(vn[0], vn[1]); Vb[1] = pack8(vn[2], vn[3]);
    LAS float* OT = (LAS float*)(F.lds + PO_OT);
#pragma unroll
    for (int mt = 0; mt < 4; ++mt) {
        f32x4 o = (f32x4){0.f, 0.f, 0.f, 0.f};
#pragma unroll
        for (int ks = 0; ks < 4; ++ks) o = __builtin_amdgcn_mfma_f32_16x16x32_bf16(*(const LAS bf16x8*)(fl + 16384 + (mt * 4 + ks) * 1024), Sb[ks], o, 0, 0, 0);
#pragma unroll
        for (int k2 = 0; k2 < 2; ++k2) o = __builtin_amdgcn_mfma_f32_16x16x32_bf16(*(const LAS bf16x8*)(fl + 32768 + (mt * 2 + k2) * 1024), Vb[k2], o, 0, 0, 0);
#pragma unroll
        for (int r = 0; r < 4; ++r) OT[(16 * mt + 4 * q + r) * 132 + 16 * s + l15] = o[r];
    }
    __syncthreads();
    {
        const int row = F.tid >> 3, seg = F.tid & 7, tabs = 64 * n + row;
        const LAS float* orow = OT + row * 132 + 16 * seg;
        float o[16];
#pragma unroll
        for (int i = 0; i < 4; ++i) { const f32x4 v = *(const LAS f32x4*)(orow + 4 * i); o[4 * i] = v[0]; o[4 * i + 1] = v[1]; o[4 * i + 2] = v[2]; o[4 * i + 3] = v[3]; }
        float ss = 0.f;
#pragma unroll
        for (int i = 0; i < 16; ++i) ss += o[i] * o[i];
        ss += __shfl_xor(ss, 1); ss += __shfl_xor(ss, 2); ss += __shfl_xor(ss, 4);
        {
            const float rs = rsqrtf(ss * (1.f / 128.f) + EPS);
            const bf16_t* zp = (const bf16_t*)(F.ws + WS_PZ) + ((size_t)b * SEQ + tabs - TREAL) * 512 + h * 128 + 16 * seg;
            float z[16]; { float t8[8]; unpack8(__builtin_nontemporal_load((const u32x4*)zp), t8);
#pragma unroll
                for (int i = 0; i < 8; ++i) z[i] = t8[i];
                unpack8(__builtin_nontemporal_load((const u32x4*)(zp + 8)), t8);
#pragma unroll
                for (int i = 0; i < 8; ++i) z[8 + i] = t8[i]; }
            float y[16];
#pragma unroll
            for (int i = 0; i < 16; ++i) y[i] = o[i] * rs * nw[i] * silu_f(z[i]);
            bf16_t* yp = (bf16_t*)(F.ws + WS_YCAT) + ((size_t)b * SEQ + tabs - TREAL) * DM + 512 + h * 128 + 16 * seg;
            u32x4 w0, w1; w0.x = cvt_pk_bf16(y[0], y[1]); w0.y = cvt_pk_bf16(y[2], y[3]); w0.z = cvt_pk_bf16(y[4], y[5]); w0.w = cvt_pk_bf16(y[6], y[7]);
            w1.x = cvt_pk_bf16(y[8], y[9]); w1.y = cvt_pk_bf16(y[10], y[11]); w1.z = cvt_pk_bf16(y[12], y[13]); w1.w = cvt_pk_bf16(y[14], y[15]);
            *(u32x4*)yp = w0; *(u32x4*)(yp + 8) = w1;
        }
    }
    __syncthreads();
}

__device__ __forceinline__ void pe_convert(Frame& F, const Args& a, int witem0, int nwaves, int it_begin, int it_end) {
    LAS float* scr = (LAS float*)(F.lds + F.wave * TR_SCR);
    bf16_t* WGU = (bf16_t*)(F.ws + WS_WE); bf16_t* WDN = (bf16_t*)(F.ws + WS_WED);
    for (int it = it_begin + witem0; it < it_end; it += nwaves) {
        const int e = it / 384; int r = it % 384;
        if (r < 256) { const int up = r >> 7; r &= 127; const int k0 = 64 * (r >> 3), n0 = 64 * (r & 7);
            transpose_tile64<true>(a.in[up ? I_WU : I_WG] + (size_t)e * DM * DEXP, DEXP, DM, WGU + (size_t)e * DM * DM, a.in[I_FFNNW], scr, k0, n0, 256 * (n0 >> 7) + 128 * up + (n0 & 127), F.lane); }
        else { r -= 256; const int k0 = 64 * (r >> 4), n0 = 64 * (r & 15);
            transpose_tile64<true>(a.in[I_WD] + (size_t)e * DEXP * DM, DM, DEXP, WDN + (size_t)e * DM * DEXP, nullptr, scr, k0, n0, n0, F.lane); }
    }
}

constexpr int P6_PART = 0, P6_SS = 98304, P6_HIST = 100352, P6_BASE = 100480, P6_TLO = 100608, P6_THI = 100736, P6_POS = 100864, P6_RS = 101376;
constexpr int CW_TOF = 8192, TOF_LD = 132, CW_TCNT = 12544;
__device__ __forceinline__ void p6_router(Frame& F, const Args& a) {
    const bf16_t* h1 = (const bf16_t*)(F.ws + WS_H1B); const bf16x8* WRF = (const bf16x8*)(F.ws + WS_WRF);
    LAS float* part = (LAS float*)(F.lds + P6_PART); LAS float* ssp = (LAS float*)(F.lds + P6_SS);
    LAS int* hist = (LAS int*)(F.lds + P6_HIST); LAS int* basel = (LAS int*)(F.lds + P6_BASE); LAS int* tlo = (LAS int*)(F.lds + P6_TLO); LAS int* thi = (LAS int*)(F.lds + P6_THI);
    LAS int* posl = (LAS int*)(F.lds + P6_POS);
    unsigned* ctl = (unsigned*)(F.ws + WS_CTL);
    unsigned* gcnt = ctl + CW_CNT; unsigned* tof = ctl + CW_TOF; unsigned* tcnt = ctl + CW_TCNT; int* tile_expert = (int*)(F.ws + WS_TILE);
    bf16_t* XS = (bf16_t*)(F.ws + WS_XS);
    const int l15 = F.lane & 15, q = F.lane >> 4;
    for (int wu = F.vcu; wu < MT / 64; wu += F.G) {
        const int m0 = wu * 64;
        if (F.tid < 32) hist[F.tid] = 0;
        u32x4 ab[4][4]; bf16x8 bw[4][6];
#pragma unroll
        for (int tg = 0; tg < 4; ++tg)
#pragma unroll
            for (int ksl = 0; ksl < 4; ++ksl) ab[tg][ksl] = *(const u32x4*)(h1 + (size_t)(m0 + 16 * tg + l15) * DM + 128 * F.wave + 32 * ksl + 8 * q);
#pragma unroll
        for (int ksl = 0; ksl < 4; ++ksl)
#pragma unroll
            for (int i = 0; i < 6; ++i) bw[ksl][i] = WRF[(size_t)((4 * F.wave + ksl) * 6 + i) * 64 + F.lane];
#pragma unroll
        for (int tg = 0; tg < 4; ++tg) {
            f32x4 acc[3]; acc[0] = acc[1] = acc[2] = (f32x4){0.f, 0.f, 0.f, 0.f}; float ssq = 0.f;
#pragma unroll
            for (int ksl = 0; ksl < 4; ++ksl) {
                float af[8]; unpack8(ab[tg][ksl], af);
#pragma unroll
                for (int i = 0; i < 8; ++i) ssq += af[i] * af[i];
                const bf16x8 av = __builtin_bit_cast(bf16x8, ab[tg][ksl]);
#pragma unroll
                for (int nt = 0; nt < 3; ++nt) { acc[nt] = __builtin_amdgcn_mfma_f32_16x16x32_bf16(av, bw[ksl][2 * nt], acc[nt], 0, 0, 0); acc[nt] = __builtin_amdgcn_mfma_f32_16x16x32_bf16(av, bw[ksl][2 * nt + 1], acc[nt], 0, 0, 0); }
            }
            ssq += __shfl_xor(ssq, 16); ssq += __shfl_xor(ssq, 32);
#pragma unroll
            for (int nt = 0; nt < 3; ++nt)
#pragma unroll
                for (int r = 0; r < 4; ++r) part[((F.wave * 64 + 16 * tg) + 4 * q + r) * 48 + 16 * nt + l15] = acc[nt][r];
            if (q == 0) ssp[F.wave * 64 + 16 * tg + l15] = ssq;
        }
        __syncthreads();
        int e0 = 0, e1 = 0, ls0 = 0, ls1 = 0; float w0 = 0.f, w1 = 0.f, rstd = 0.f;
        if (F.tid < 64) {
            const LAS float* pa = part + F.tid * 48; float sq = 0.f;
#pragma unroll
            for (int w8 = 0; w8 < 8; ++w8) sq += ssp[w8 * 64 + F.tid];
            rstd = rsqrtf(sq * (1.f / DM) + EPS);
            float lg[4]; float mx = -3.0e38f; int gs = 0;
#pragma unroll
            for (int c = 0; c < 4; ++c) { float sv = 0.f;
#pragma unroll
                for (int w8 = 0; w8 < 8; ++w8) sv += pa[w8 * 64 * 48 + c];
                lg[c] = sv * rstd + a.in[I_BGRP][c]; if (lg[c] > mx) { mx = lg[c]; gs = c; } }
            float ps = 0.f;
#pragma unroll
            for (int c = 0; c < 4; ++c) ps += __expf(lg[c] - mx);
            const float pg = 1.f / ps;
            float le[8]; float m1 = -3.0e38f; int i1 = 0;
#pragma unroll
            for (int e = 0; e < 8; ++e) { float sv = 0.f;
#pragma unroll
                for (int w8 = 0; w8 < 8; ++w8) sv += pa[w8 * 64 * 48 + 4 + 8 * gs + e];
                le[e] = sv * rstd + a.in[I_BRT][8 * gs + e]; if (le[e] > m1) { m1 = le[e]; i1 = e; } }
            float m2 = -3.0e38f; int i2 = 0;
#pragma unroll
            for (int e = 0; e < 8; ++e) if (e != i1 && le[e] > m2) { m2 = le[e]; i2 = e; }
            const float x2 = __expf(m2 - m1), inv = pg / (1.f + x2);
            w0 = inv; w1 = x2 * inv; e0 = 8 * gs + i1; e1 = 8 * gs + i2;
            ls0 = __hip_atomic_fetch_add(hist + e0, 1, __ATOMIC_RELAXED, __HIP_MEMORY_SCOPE_WORKGROUP);
            ls1 = __hip_atomic_fetch_add(hist + e1, 1, __ATOMIC_RELAXED, __HIP_MEMORY_SCOPE_WORKGROUP);
        }
        __syncthreads();
        if (F.tid < 32) {
            const int e = F.tid, hcnt = hist[e]; int base = 0, t_lo = 0, t_hi = 0;
            if (hcnt) {
                base = (int)__hip_atomic_fetch_add(gcnt + 64 * e, (unsigned)hcnt, RLX_AGENT);
                const int j0 = base >> 8, j1 = (base + hcnt - 1) >> 8;
                if ((base & 255) == 0) { t_lo = (int)__hip_atomic_fetch_add(tcnt, 1u, RLX_AGENT); tile_expert[t_lo] = (j0 << 8) | e; __hip_atomic_store(tof + e * TOF_LD + j0, (unsigned)t_lo + 1u, RLX_AGENT); }
                if (j1 > j0) { t_hi = (int)__hip_atomic_fetch_add(tcnt, 1u, RLX_AGENT); tile_expert[t_hi] = (j1 << 8) | e; __hip_atomic_store(tof + e * TOF_LD + j1, (unsigned)t_hi + 1u, RLX_AGENT); }
                if ((base & 255) != 0) { unsigned v = 0, sp = 0;
                    while ((v = __hip_atomic_load(tof + e * TOF_LD + j0, RLX_AGENT)) == 0u) { __builtin_amdgcn_s_sleep(1); if (++sp > (1u << 22)) break; }
                    t_lo = (int)v - 1; }
            }
            basel[e] = base; tlo[e] = t_lo; thi[e] = t_hi;
        }
        __syncthreads();
        if (F.tid < 64) { const int m = m0 + F.tid;
            const int b0 = basel[e0], s0 = b0 + ls0, b1 = basel[e1], s1 = b1 + ls1;
            const int p0 = 256 * ((s0 >> 8) == (b0 >> 8) ? tlo[e0] : thi[e0]) + (s0 & 255), p1 = 256 * ((s1 >> 8) == (b1 >> 8) ? tlo[e1] : thi[e1]) + (s1 & 255);
            posl[2 * F.tid] = p0; posl[2 * F.tid + 1] = p1;
            ((float*)(F.ws + WS_EW))[2 * m] = w0; ((float*)(F.ws + WS_EW))[2 * m + 1] = w1;
            ((int*)(F.ws + WS_POS))[2 * m] = p0; ((int*)(F.ws + WS_POS))[2 * m + 1] = p1;
            ((float*)(F.ws + WS_RSC))[p0] = rstd; ((float*)(F.ws + WS_RSC))[p1] = rstd;
            ((int*)(F.ws + WS_TOKOF))[p0] = m; ((int*)(F.ws + WS_TOKOF))[p1] = m; }
        __syncthreads();
        __syncthreads();
    }
}

__device__ __forceinline__ void p10_combine(Frame& F, const Args& a, float* outp) {
    const int gw = F.vcu * 8 + F.wave, NGW = F.G * 8;
    const bf16_t* h1 = (const bf16_t*)(F.ws + WS_H1B); const bf16_t* Y = (const bf16_t*)(F.ws + WS_XS);
    f32x4 fw[4];
#pragma unroll
    for (int j = 0; j < 4; ++j) fw[j] = ((const f32x4*)a.in[I_FINNW])[64 * j + F.lane];
    const int* POS = (const int*)(F.ws + WS_POS); const float* EW = (const float*)(F.ws + WS_EW);
    int pa0 = 0, pa1 = 0; float wa0 = 0.f, wa1 = 0.f;
    u32x2 vb[4]; u32x2 ya[4], yb[4]; float wb0 = 0.f, wb1 = 0.f;
    int m = gw;
    if (m < MT) { pa0 = POS[2 * m]; pa1 = POS[2 * m + 1]; wa0 = EW[2 * m]; wa1 = EW[2 * m + 1]; }
#define P10_LOAD_ROWS(mm) do { const u32x2* row_ = (const u32x2*)(h1 + (size_t)(mm) * DM); const u32x2* y0_ = (const u32x2*)(Y + (size_t)pa0 * DM); const u32x2* y1_ = (const u32x2*)(Y + (size_t)pa1 * DM); \
        _Pragma("unroll") for (int j = 0; j < 4; ++j) { vb[j] = __builtin_nontemporal_load(row_ + 64 * j + F.lane); ya[j] = __builtin_nontemporal_load(y0_ + 64 * j + F.lane); yb[j] = __builtin_nontemporal_load(y1_ + 64 * j + F.lane); } wb0 = wa0; wb1 = wa1; } while (0)
    if (m < MT) { P10_LOAD_ROWS(m); const int m1 = m + NGW; if (m1 < MT) { pa0 = POS[2 * m1]; pa1 = POS[2 * m1 + 1]; wa0 = EW[2 * m1]; wa1 = EW[2 * m1 + 1]; } }
    for (; m < MT; m += NGW) {
        f32x4 v[4]; u32x2 a0[4], a1[4]; const float w0 = wb0, w1 = wb1;
#pragma unroll
        for (int j = 0; j < 4; ++j) { v[j] = (f32x4){bf_lo(vb[j].x), bf_hi(vb[j].x), bf_lo(vb[j].y), bf_hi(vb[j].y)}; a0[j] = ya[j]; a1[j] = yb[j]; }
        const int m1 = m + NGW, m2 = m + 2 * NGW;
        if (m1 < MT) { P10_LOAD_ROWS(m1); if (m2 < MT) { pa0 = POS[2 * m2]; pa1 = POS[2 * m2 + 1]; wa0 = EW[2 * m2]; wa1 = EW[2 * m2 + 1]; } }
        float ss = 0.f;
#pragma unroll
        for (int j = 0; j < 4; ++j) {
            v[j][0] += w0 * bf_lo(a0[j].x) + w1 * bf_lo(a1[j].x); v[j][1] += w0 * bf_hi(a0[j].x) + w1 * bf_hi(a1[j].x);
            v[j][2] += w0 * bf_lo(a0[j].y) + w1 * bf_lo(a1[j].y); v[j][3] += w0 * bf_hi(a0[j].y) + w1 * bf_hi(a1[j].y);
            ss += (v[j][0] * v[j][0] + v[j][1] * v[j][1]) + (v[j][2] * v[j][2] + v[j][3] * v[j][3]); }
        ss = wave_sum(ss);
        const float rs = rsqrtf(ss * (1.f / DM) + EPS);
#pragma unroll
        for (int j = 0; j < 4; ++j) __builtin_nontemporal_store(v[j] * rs * fw[j], (f32x4*)(outp + (size_t)m * DM) + 64 * j + F.lane);
    }
#undef P10_LOAD_ROWS
}

__global__ void __launch_bounds__(512, 2) mk_fwd(Args args) {
    extern __shared__ __attribute__((aligned(16))) unsigned char lds[];
    Frame F;
    F.lds = (LAS unsigned char*)lds;
    F.tid = threadIdx.x; F.lane = F.tid & 63; F.wave = __builtin_amdgcn_readfirstlane(F.tid >> 6);
    F.G = gridDim.x; { const int bx = blockIdx.x; F.vcu = (F.G % 8 == 0) ? (bx % 8) * (F.G / 8) + bx / 8 : bx; }
    F.ws = args.ws; F.dob = (unsigned char*)args.out;
    volatile LAS unsigned* MISC = (volatile LAS unsigned*)(F.lds + LDSCTL_OFF);
    if (F.tid < 16) MISC[F.tid] = 0u;
    __syncthreads();
    unsigned* ctl = (unsigned*)(F.ws + WS_CTL);
    XcdBarrier bar; bar.bar = ctl + CW_BAR; bar.x = 0; bar.st = nullptr;
    const int lo = args.ph_lo, hi = args.ph_hi;
    const bool use_bar = (hi - lo) > 1;
    if (use_bar) bar = xcd_barrier_post(ctl + CW_BAR, MISC + 8);
#define IN(k) (lo <= (k) && (k) < hi)
#define SCAN_ROLES() do { if (F.wave == 0) p4_scan_c(F, bh, sl); else if (F.wave == 1) p4_scan_loader<0>(F, bh, sl); else if (F.wave == 2) p4_scan_loader<1>(F, bh, sl); else if (F.wave == 3) p4_scan_loader<2>(F, bh, sl); \
    else if (F.wave == 5) p4_scan_loader<3>(F, bh, sl); else if (F.wave == 6) p4_scan_loader<4>(F, bh, sl); else if (F.wave == 7) p4_scan_loader<5>(F, bh, sl); } while (0)
#define REP(k) for (int rep_ = 0; rep_ < 1 + ((MK_REPEAT_MASK >> (k)) & 1); ++rep_)
#define SEAM(k) do { if (IN(k) && IN((k) + 1)) xcd_barrier(bar); } while (0)

    if (IN(0)) REP(0) { p0_prologue(F, args); }
    SEAM(0);
    if (IN(1)) REP(1) {
        pg8::Gemm g{(const bf16_t*)(F.ws + WS_XB), (const bf16_t*)(F.ws + WS_WIN), DM};
        pg8::DenseOrder S; S.init(MT / 256, 12, DM, F.G, (int)blockIdx.x);
        pg8::EpiProj E{(bf16_t*)(F.ws + WS_PA), (bf16_t*)(F.ws + WS_PQ), (const float*)(F.ws + WS_RSTD1)};
        pg8::gemm_phase<pg8::EpiProj, pg8::DenseOrder>(F.lds, g, S, E);
    }
    SEAM(1);
    if (IN(2)) REP(2) {
        p3_phase(F, args);
#if MK_PROBE_P2 == 1
        p3_phase(F, args);
#endif
        p2_mixer_a(F, args);
#if MK_PROBE_P2 == 2
        p2_mixer_a(F, args);
#endif
    }
    SEAM(2);
    if (IN(3)) REP(3) {
        if (blockIdx.x < 64) {
            if (F.tid < 9) lds_st_u32((unsigned)(size_t)(F.lds + SC_CTL) + 4 * F.tid, 0u);
            __syncthreads();
            const int bh = (int)(blockIdx.x & 7), sl = (int)(blockIdx.x >> 3);
            SCAN_ROLES();
#if MK_PROBE_P3 == 2
            __syncthreads();
            if (F.tid < 9) lds_st_u32((unsigned)(size_t)(F.lds + SC_CTL) + 4 * F.tid, 0u);
            __syncthreads();
            SCAN_ROLES();
#endif
        }
        else {
            const int j = (int)blockIdx.x - 64, nwg = F.G - 64, nz = nwg >= 192 ? 128 : (nwg * 2) / 3, ne = nwg - nz;
            constexpr int NIT = NEXP * 384;
            const int n_early = (int)((long)NIT * 5 / 12);
            if (j < nz) {
                pg8::Gemm g{(const bf16_t*)(F.ws + WS_XB), (const bf16_t*)(F.ws + WS_WIN), DM};
                const int jx = (nz % 8 == 0) ? (j % 8) * (nz / 8) + j / 8 : j;
                pg8::ZOrder S{jx, nz};
                pg8::EpiZ E{(bf16_t*)(F.ws + WS_PZ), (const float*)(F.ws + WS_RSTD1)};
                pg8::gemm_phase<pg8::EpiZ, pg8::ZOrder>(F.lds, g, S, E);
                __syncthreads();
                pe_convert(F, args, j * 8 + F.wave, nz * 8, n_early, NIT);
            } else {
                pe_convert(F, args, (j - nz) * 8 + F.wave, ne * 8, 0, n_early);
            }
        }
    }
    SEAM(3);
    if (IN(4)) REP(4) {
        float nw[16];
#pragma unroll
        for (int i = 0; i < 16; ++i) nw[i] = args.in[I_GDNNW][16 * (F.tid & 7) + i];
        for (int u = F.vcu; u < 8 * (NCHUNK - 1); u += F.G) p4_out_unit(F, args, (u >> 7) * NCHUNK + 1 + (u & 127), nw);
    }
    SEAM(4);
    if (IN(5)) REP(5) {
        pg8::Gemm g{(const bf16_t*)(F.ws + WS_YCAT), (const bf16_t*)(F.ws + WS_WOUT), DM};
        pg8::DenseOrder S; S.init(MT / 256, DM / 256, DM, F.G, (int)blockIdx.x);
        pg8::EpiRes E{(const bf16_t*)(F.ws + WS_XB), (bf16_t*)(F.ws + WS_H1B)};
        pg8::gemm_phase<pg8::EpiRes, pg8::DenseOrder>(F.lds, g, S, E);
    }
    SEAM(5);
    if (IN(6)) { p6_router(F, args); }
    SEAM(6);
    LAS int* tile_l = (LAS int*)(F.lds + LDS_TILE_OFF);
    LAS int* tval_l = (LAS int*)(F.lds + LDS_TVAL_OFF); LAS int* tord_l = (LAS int*)(F.lds + LDS_TORD_OFF);
    if (IN(8) || IN(9)) {
        if (F.tid < 255) { const int nt_ = (int)ld_agent((const unsigned*)(F.ws + WS_CTL) + CW_TCNT); int te = 0, tv = 0;
            if (F.tid < nt_) { const int pk = ld_agent((const int*)(F.ws + WS_TILE) + F.tid); te = pk & 255;
                const int cnt = (int)ld_agent((const unsigned*)(F.ws + WS_CTL) + CW_CNT + 64 * te) - 256 * (pk >> 8); tv = cnt < 0 ? 0 : (cnt > 256 ? 256 : cnt); }
            tile_l[F.tid] = te; tval_l[F.tid] = tv; }
        if (F.tid == 255) tile_l[255] = (int)ld_agent((const unsigned*)(F.ws + WS_CTL) + CW_TCNT);
        __syncthreads();
        { const int nt_ = tile_l[255]; if (F.tid < nt_) { const int me = tile_l[F.tid]; int rank = 0;
              for (int j = 0; j < nt_; ++j) { const int ej = tile_l[j]; rank += (ej < me || (ej == me && j < F.tid)) ? 1 : 0; }
              tord_l[rank] = F.tid; } }
        __syncthreads(); }
    if (IN(8)) REP(8) {
        pg8::Gemm g{(const bf16_t*)(F.ws + WS_H1B), (const bf16_t*)(F.ws + WS_WE), DM};
        pg8::MoeOrder S{tile_l, tord_l, tile_l[255], 4, F.G, F.vcu, 256u * DM * 2u, (unsigned)DM * DM * 2u, (unsigned*)(F.ws + WS_CTL) + CW_HC, (const int*)(F.ws + WS_TOKOF)};
        pg8::EpiGU E{(bf16_t*)(F.ws + WS_HID), (const float*)(F.ws + WS_RSC), tval_l};
        pg8::gemm_phase<pg8::EpiGU, pg8::MoeOrder>(F.lds, g, S, E);
    }
    if (IN(9)) REP(9) {
        pg8::Gemm g{(const bf16_t*)(F.ws + WS_HID), (const bf16_t*)(F.ws + WS_WED), DEXP};
        const int U8 = 4 * tile_l[255];
        pg8::MoeOrderDown S{tile_l, tord_l, U8, F.G, F.vcu, U8 % F.G, 256u * DEXP * 2u, (unsigned)DM * DEXP * 2u, (const unsigned*)(F.ws + WS_CTL) + CW_HC, (unsigned*)(F.ws + WS_CTL) + CW_BAR + XB_TMO};
        pg8::EpiBf16 E{(bf16_t*)(F.ws + WS_XS), DM, tval_l};
        pg8::gemm_phase<pg8::EpiBf16, pg8::MoeOrderDown>(F.lds, g, S, E);
    }
    SEAM(9);
    if (IN(10)) { if ((MK_REPEAT_MASK >> 10) & 1) p10_combine(F, args, (float*)(F.ws + WS_WE)); p10_combine(F, args, (float*)F.dob); }
#undef IN
#undef REP
#undef SEAM
}

extern "C" void kernel_launch(void* const* d_in, const int* in_sizes, int n_in, void* d_out, int out_size, void* d_ws, size_t ws_size, hipStream_t stream) {
    static int grid = 0;
    if (grid == 0) {
        if (n_in != 20 || out_size != MT * DM || ws_size < WS_END) { fprintf(stderr, "kernel_launch: unexpected shapes (n_in %d, out %d, ws %zu)\n", n_in, out_size, ws_size); grid = -1; return; }
        int dev = 0, cus = 0, per_cu = 0;
        if (hipGetDevice(&dev) != hipSuccess || hipDeviceGetAttribute(&cus, hipDeviceAttributeMultiprocessorCount, dev) != hipSuccess) { grid = -1; return; }
        if (hipFuncSetAttribute((const void*)mk_fwd, hipFuncAttributeMaxDynamicSharedMemorySize, LDS_BYTES) != hipSuccess) { grid = -1; return; }
        if (hipOccupancyMaxActiveBlocksPerMultiprocessor(&per_cu, (const void*)mk_fwd, 512, LDS_BYTES) != hipSuccess || per_cu < 1) { fprintf(stderr, "kernel_launch: occupancy query says %d\n", per_cu); }
        (void)hipGetLastError();
        grid = cus;
        if (grid < 64) { grid = -1; return; }
    }
    if (grid < 0) return;
    (void)hipMemsetAsync((char*)d_ws + WS_CTL, 0, CTL_ZERO_BYTES, stream);
    Args a{};
    for (int i = 0; i < 20; ++i) a.in[i] = (const float*)d_in[i];
    a.out = (float*)d_out; a.ws = (unsigned char*)d_ws;
    if (MK_N_LAUNCHES == 1) { a.ph_lo = 0; a.ph_hi = NPHASE; hipLaunchKernelGGL(mk_fwd, dim3(grid), dim3(512), LDS_BYTES, stream, a); }
    else for (int p = 0; p < NPHASE; ++p) { a.ph_lo = p; a.ph_hi = p + 1; hipLaunchKernelGGL(mk_fwd, dim3(grid), dim3(512), LDS_BYTES, stream, a); }
}
```

```cpp
#include <hip/hip_runtime.h>
#include <cstdio>
#include <cstdint>

#ifndef MK_N_LAUNCHES
#define MK_N_LAUNCHES 1
#endif
#ifndef MK_PROBE_P2
#define MK_PROBE_P2 0
#endif
#ifndef MK_PROBE_P3
#define MK_PROBE_P3 0
#endif
#ifndef MK_REPEAT_MASK
#define MK_REPEAT_MASK 0
#endif

#define GAS __attribute__((address_space(1)))
#define LAS __attribute__((address_space(3)))
typedef unsigned short bf16_t;
typedef short bf16x8 __attribute__((ext_vector_type(8)));
typedef float f32x4 __attribute__((ext_vector_type(4)));
typedef unsigned u32x4 __attribute__((ext_vector_type(4)));
typedef unsigned u32x2 __attribute__((ext_vector_type(2)));

constexpr int NB = 2, SEQ = 8192, NMETA = 16, DM = 1024;
constexpr int TPAD = 48, TREAL = TPAD + NMETA;
constexpr int NCHUNK = 129, LP = NCHUNK * 64;
constexpr int MR = NB * LP;
constexpr int MRP = 65 * 256;
constexpr int MT = NB * SEQ;
constexpr int NPROJ = 3584;
constexpr int PROJ_LD = 3592;
constexpr int NEXP = 32, DEXP = 512;
constexpr int ROWS_CAP = 160 * 256;
constexpr int NUNIT_GDN = 8 * NCHUNK;
constexpr float EPS = 1e-6f;
constexpr int NPHASE = 11;

constexpr size_t MiB = 1u << 20;
constexpr size_t WS_CTL = 0, CTL_ZERO_BYTES = 65536;
constexpr size_t WS_WIN = 1 * MiB;
constexpr size_t WS_WOUT = 8 * MiB;
constexpr size_t WS_SMALL = 10 * MiB;
constexpr size_t WS_RSTD1 = WS_SMALL;
constexpr size_t WS_GB = WS_RSTD1 + 128 * 1024;
constexpr size_t WS_WRF = WS_GB + 640 * 1024;
constexpr size_t WS_RSTD2 = WS_WRF + 256 * 1024;
constexpr size_t WS_EIDX = WS_RSTD2 + 64 * 1024;
constexpr size_t WS_EW = WS_EIDX + 128 * 1024;
constexpr size_t WS_SLOT = WS_EW + 128 * 1024;
constexpr size_t WS_POS = WS_SLOT + 128 * 1024;
constexpr size_t WS_RSC = WS_POS + 128 * 1024;
constexpr size_t WS_TILE = WS_RSC + 192 * 1024;
constexpr size_t WS_ALAST = WS_TILE + 4096;
constexpr size_t WS_TOKOF = WS_ALAST + 8192;
static_assert(WS_TOKOF + ROWS_CAP * 4 <= 16 * MiB, "small region");
constexpr size_t WS_XB = 16 * MiB;
constexpr size_t WS_YCAT = 48 * MiB;
constexpr size_t WS_PZ = 80 * MiB;
constexpr size_t WS_KD = 240 * MiB;
constexpr size_t WS_IN = 256 * MiB + 512 * 1024;
constexpr size_t WS_PA = 109 * MiB;
constexpr size_t WS_PQ = 158 * MiB;
constexpr size_t WS_WE = 96 * MiB + 512 * 1024;
constexpr size_t WS_WED = WS_WE + 64 * MiB;
constexpr size_t WS_XS = 16 * MiB;
constexpr size_t WS_HID = 192 * MiB + 512 * 1024;
constexpr size_t WS_SFR = 207 * MiB;
constexpr size_t WS_H1B = 232 * MiB + 512 * 1024;
constexpr size_t WS_END = 265 * MiB;
constexpr size_t DO_W = 0, DO_U = 17 * MiB, DO_QG = 34 * MiB;

constexpr int CW_BAR = 0;
constexpr int CW_CNT = 4096;
constexpr int CW_HC = 14080;

constexpr int RING_BYTES = 131072;
constexpr int LDS_BYTES = 147456;
constexpr int LDSCTL_OFF = LDS_BYTES - 3328;
constexpr int LDS_TILE_OFF = LDSCTL_OFF + 256;
constexpr int LDS_TORD_OFF = LDS_TILE_OFF + 2048;
constexpr int LDS_TVAL_OFF = LDS_TILE_OFF + 1024;
constexpr int SC_SLOT = 34816, SC_CTL = 4 * SC_SLOT;
static_assert(SC_CTL + 64 <= LDSCTL_OFF, "scan ring vs control words");

#define LDS_WAIT() asm volatile("s_waitcnt lgkmcnt(0)" ::: "memory")
#define VM_WAIT() asm volatile("s_waitcnt vmcnt(0)" ::: "memory")
#define RLX_AGENT __ATOMIC_RELAXED, __HIP_MEMORY_SCOPE_AGENT

typedef __bf16 bf16x2_t __attribute__((ext_vector_type(2)));
typedef float f32x2_t __attribute__((ext_vector_type(2)));
__device__ __forceinline__ unsigned cvt_pk_bf16(float lo, float hi) { const f32x2_t f = {lo, hi}; const bf16x2_t v = __builtin_convertvector(f, bf16x2_t); return __builtin_bit_cast(unsigned, v); }
__device__ __forceinline__ float bf_lo(unsigned u) { return __uint_as_float(u << 16); }
__device__ __forceinline__ float bf_hi(unsigned u) { return __uint_as_float(u & 0xffff0000u); }
__device__ __forceinline__ float wave_sum(float v) {
#pragma unroll
    for (int o = 1; o < 64; o <<= 1) v += __shfl_xor(v, o);
    return v;
}
__device__ __forceinline__ float silu_f(float x) { return x * __builtin_amdgcn_rcpf(1.f + __expf(-x)); }
template <class T> __device__ __forceinline__ T ld_agent(const T* p) { return __hip_atomic_load(p, RLX_AGENT); }

#define XB_TMO      128
#define XB_XCNT(j)  (256  + 64 * (j))
#define XB_XSUB(j)  (1280 + 64 * (j))
#define XB_XGEN(j)  (2304 + 64 * (j))
#define XB_TOP      3328
#define XB_TOPGEN   3392
#define XCD_BAR_WORDS 3456
#define XB_SPIN_CAP (1u << 18)
__device__ __forceinline__ unsigned xb_ld(unsigned* p)              { return __hip_atomic_load(p, __ATOMIC_RELAXED, __HIP_MEMORY_SCOPE_AGENT); }
__device__ __forceinline__ unsigned xb_add(unsigned* p, unsigned v) { return __hip_atomic_fetch_add(p, v, __ATOMIC_RELAXED, __HIP_MEMORY_SCOPE_AGENT); }
__device__ __forceinline__ unsigned xb_xcc_id() { return (unsigned)__builtin_amdgcn_s_getreg((3 << 11) | 20) & 0xFu; }
#define XB_SPIN(cond, bar) do { unsigned _sp = 0; while (cond) { __builtin_amdgcn_s_sleep(1); \
    if ((++_sp & 255u) == 0u) { if (xb_ld(&(bar)[XB_TMO])) break; if (_sp > XB_SPIN_CAP) { atomicAdd(&(bar)[XB_TMO], 1u); break; } } } } while (0)
struct XcdBarrier { unsigned* bar; unsigned x; volatile LAS unsigned* st; };
__device__ __forceinline__ XcdBarrier xcd_barrier_post(unsigned* bar, volatile LAS unsigned* st) {
    XcdBarrier b; b.bar = bar; b.x = xb_xcc_id(); b.st = st;
    if (threadIdx.x == 0) (void)xb_add(&bar[XB_XCNT(b.x)], 1u);
    return b;
}
__device__ __forceinline__ void xcd_barrier_complete(unsigned* bar, unsigned x, unsigned& nloc, unsigned& nx) {
    const unsigned G = gridDim.x * gridDim.y * gridDim.z;
    unsigned sum, cnt, mine, sp = 0u;
    for (;;) {
        sum = 0u; cnt = 0u; mine = 0u;
#pragma unroll
        for (unsigned j = 0; j < 16; ++j) { const unsigned c = xb_ld(&bar[XB_XCNT(j)]); sum += c; cnt += (c > 0u) ? 1u : 0u; mine = (j == x) ? c : mine; }
        if (sum == G) break;
        __builtin_amdgcn_s_sleep(1);
        if ((++sp & 255u) == 0u) { if (xb_ld(&bar[XB_TMO])) break; if (sp > XB_SPIN_CAP) { atomicAdd(&bar[XB_TMO], 1u); break; } }
    }
    nloc = mine > 0u ? mine : 1u; nx = cnt > 0u ? cnt : 1u;
}
__device__ __forceinline__ void xcd_barrier(const XcdBarrier& b) {
    asm volatile("s_waitcnt vmcnt(0)" ::: "memory");
    __syncthreads();
    if (threadIdx.x == 0) {
        unsigned* bar = b.bar;
        __builtin_amdgcn_s_waitcnt(0);
        unsigned nloc = b.st[0], nx = b.st[1];
        if (nloc == 0u) { xcd_barrier_complete(bar, b.x, nloc, nx); b.st[0] = nloc; b.st[1] = nx; }
        const unsigned old = xb_add(&bar[XB_XSUB(b.x)], 1u);
        const unsigned gen = old / nloc;
        if (old + 1u == (gen + 1u) * nloc) {
            __builtin_amdgcn_fence(__ATOMIC_RELEASE, "agent");
            asm volatile("s_waitcnt vmcnt(0)" ::: "memory");
            const unsigned og = xb_add(&bar[XB_TOP], 1u);
            const unsigned tg = og / nx;
            if (og + 1u == (tg + 1u) * nx) xb_add(&bar[XB_TOPGEN], 1u);
            else XB_SPIN(xb_ld(&bar[XB_TOPGEN]) == tg, bar);
            __builtin_amdgcn_fence(__ATOMIC_ACQUIRE, "agent");
            xb_add(&bar[XB_XGEN(b.x)], 1u);
            asm volatile("s_waitcnt vmcnt(0)" ::: "memory");
        } else {
            XB_SPIN(xb_ld(&bar[XB_XGEN(b.x)]) == gen, bar);
            __builtin_amdgcn_fence(__ATOMIC_ACQUIRE, "agent");
            asm volatile("s_waitcnt vmcnt(0)" ::: "memory");
        }
    }
    __syncthreads();
}

namespace pg8 {
constexpr int BM = 256, BK = 64, HALF = 128, HTB = HALF * BK * 2, NXCD = 8, WGM = 8;
__host__ __device__ __forceinline__ int lds_byte(int r, int c) { const int st = (r >> 4) * 2 + (c >> 5), rr = r & 15, cc = c & 31, ob = rr * 64 + cc * 2; return st * 1024 + (ob ^ (((ob >> 9) & 1) << 5)); }
__host__ __device__ __forceinline__ void stage_rc(int b, int& R, int& C) { const int st = b / 1024, sb = b % 1024, swz = sb ^ (((sb >> 9) & 1) << 5); R = (st >> 1) * 16 + swz / 64; C = (st & 1) * 32 + (swz % 64) / 2; }
__host__ __device__ __forceinline__ int perm32(int rho) { const int n = rho >> 4, i = rho & 15; return 8 * (i >> 2) + 4 * n + (i & 3); }

struct Unit { unsigned aoff, boff; int pm, pn; };
struct Gemm { const bf16_t* A; const bf16_t* Bt; int K; };

struct DenseOrder {
    static constexpr bool GATHER = false;
    int nM, nN, nwg, G, c; unsigned pstep;
    __device__ void init(int nM_, int nN_, int K, int G_, int c_) { nM = nM_; nN = nN_; nwg = nM * nN; G = G_; c = c_; pstep = 256u * (unsigned)K * 2u; }
    __device__ bool next(int i, Unit& u) const {
        const long L = (long)i * G + c; if (L >= nwg) return false;
        int wgid = (int)L; { const int q = nwg / NXCD, r = nwg % NXCD, xcd = wgid % NXCD, off = wgid / NXCD; wgid = (xcd < r ? xcd * (q + 1) : r * (q + 1) + (xcd - r) * q) + off; }
        const int nig = WGM * nN, gid = wgid / nig, fm = gid * WGM, gsz = (nM - fm) < WGM ? (nM - fm) : WGM;
        u.pm = fm + ((wgid % nig) % gsz); u.pn = (wgid % nig) / gsz; u.aoff = (unsigned)u.pm * pstep; u.boff = (unsigned)u.pn * pstep; return true;
    }
    __device__ __forceinline__ void a_ready(const Unit&) const {}
    __device__ __forceinline__ void done(const Unit&) const {}
};
struct MoeOrder {
    static constexpr bool GATHER = true;
    const LAS int* tile_e; const LAS int* tord; int ntiles, nN, G, c; unsigned pstep, estep;
    __device__ bool next(int i, Unit& u) const {
        const long L = (long)i * G + c; if (L >= (long)ntiles * nN) return false;
        const int rt = tord[(int)L / nN], pn = (int)L % nN; const int e = tile_e[rt];
        u.pm = rt; u.pn = pn; u.aoff = (unsigned)rt * pstep; u.boff = (unsigned)e * estep + (unsigned)pn * pstep; return true;
    }
    __device__ __forceinline__ void a_ready(const Unit&) const {}
    unsigned* hc; const int* tok;
    __device__ __forceinline__ void done(const Unit& u) const {
        asm volatile("s_waitcnt vmcnt(0)" ::: "memory");
        if ((threadIdx.x & 63) == 0) __hip_atomic_fetch_add(hc + u.pm, 1u, __ATOMIC_RELAXED, __HIP_MEMORY_SCOPE_AGENT);
    }
};
struct MoeOrderDown {
    static constexpr bool GATHER = false;
    const LAS int* tile_e; const LAS int* tord; int U, G, c, r; unsigned pstep, estep; const unsigned* hc; unsigned* tmo;
    __device__ bool next(int i, Unit& u) const {
        long L;
        if (c < r) L = 2L * (G - r) + (long)i * G + c;
        else L = i < 2 ? (long)i * (G - r) + (c - r) : 2L * (G - r) + (long)(i - 2) * G + c;
        if (L >= U) return false;
        const int rt = tord[(int)L >> 2], pn = (int)L & 3; const int e = tile_e[rt];
        u.pm = rt; u.pn = pn; u.aoff = (unsigned)rt * pstep; u.boff = (unsigned)e * estep + (unsigned)pn * pstep; return true;
    }
    __device__ __forceinline__ void a_ready(const Unit& u) const {
        if (threadIdx.x < 64) { unsigned sp = 0;
            while ((unsigned)__builtin_amdgcn_readfirstlane((int)__hip_atomic_load(hc + u.pm, __ATOMIC_RELAXED, __HIP_MEMORY_SCOPE_AGENT)) < 32u) {
                __builtin_amdgcn_s_sleep(8); if (++sp > (1u << 20)) { if (threadIdx.x == 0) __hip_atomic_store(tmo, 1u, __ATOMIC_RELAXED, __HIP_MEMORY_SCOPE_AGENT); break; } }
            __builtin_amdgcn_fence(__ATOMIC_ACQUIRE, "agent");
            asm volatile("s_waitcnt vmcnt(0)" ::: "memory"); }
        asm volatile("" ::: "memory"); __builtin_amdgcn_s_barrier(); asm volatile("" ::: "memory");
    }
    __device__ __forceinline__ void done(const Unit&) const {}
};

template <class Epi, class Sched>
__device__ __forceinline__ void gemm_phase(LAS unsigned char* lds, const Gemm g, const Sched& S, const Epi& E) {
    const int tid = threadIdx.x, wid = __builtin_amdgcn_readfirstlane(tid >> 6), lane = tid & 63, wr = wid >> 2, wc = wid & 3, fr = lane & 15, fq = lane >> 4;
    const int K = g.K, nt = K / BK;
    unsigned voffA[2], voffB[2];
#pragma unroll
    for (int i = 0; i < 2; ++i) { int R, C; stage_rc(tid * 16 + i * 8192, R, C); const int Rb = Epi::PERM ? ((R & ~31) + perm32(R & 31)) : R;
        voffA[i] = (unsigned)(R * K + C) * 2u; voffB[i] = (unsigned)(Rb * K + C) * 2u; }
    const size_t kstep = (size_t)(BK * 2);
    const size_t hstep = (size_t)HALF * K * 2;
    const unsigned ldsw = (unsigned)wid * 1024u;
    unsigned cG[2][2], nG[2][2]; int gR[2], gC[2];
    if constexpr (Sched::GATHER) {
#pragma unroll
        for (int i = 0; i < 2; ++i) { int R, C; stage_rc(tid * 16 + i * 8192, R, C); gR[i] = R; gC[i] = C * 2; } }
#define PG8_GIDX(dst, un) do { _Pragma("unroll") for (int _h = 0; _h < 2; ++_h) _Pragma("unroll") for (int _i = 0; _i < 2; ++_i) dst[_h][_i] = (unsigned)S.tok[(un).pm * 256 + 128 * _h + gR[_i]]; } while (0)
#define PG8_GOFF(dst) do { _Pragma("unroll") for (int _h = 0; _h < 2; ++_h) _Pragma("unroll") for (int _i = 0; _i < 2; ++_i) { unsigned _t = dst[_h][_i]; _t = _t < (unsigned)(MT - 1) ? _t : (unsigned)(MT - 1); \
        dst[_h][_i] = _t * (unsigned)(K * 2) + (unsigned)gC[_i]; } } while (0)
#define PG8_STAGE_G(bufoff, koff, v0, v1) do { \
        __builtin_amdgcn_global_load_lds((const unsigned*)((const char*)g.A + (koff) + (v0)), (LAS unsigned*)(lds + (bufoff) + ldsw), 16, 0, 0); \
        __builtin_amdgcn_global_load_lds((const unsigned*)((const char*)g.A + (koff) + (v1)), (LAS unsigned*)(lds + (bufoff) + ldsw + 8192), 16, 0, 0); } while (0)
    const int aoff = lds_byte(wr * 64 + fr, fq * 8), boff = lds_byte(wc * 32 + fr, fq * 8);
#define PG8_SA(b, h) (((b) * 2 + (h)) * HTB)
#define PG8_SB(b, h) ((4 + (b) * 2 + (h)) * HTB)
#define PG8_STAGE(bufoff, gbase, voff) do { _Pragma("unroll") for (int _i = 0; _i < 2; ++_i) \
        __builtin_amdgcn_global_load_lds((const unsigned*)((const char*)(gbase) + (voff)[_i]), (LAS unsigned*)(lds + (bufoff) + ldsw + _i * 8192), 16, 0, 0); } while (0)
#define PG8_LDA(dst, b, h) do { _Pragma("unroll") for (int m = 0; m < 4; ++m) _Pragma("unroll") for (int k = 0; k < 2; ++k) dst[m][k] = *(const LAS bf16x8*)(lds + PG8_SA(b, h) + aoff + m * 2048 + k * 1024); } while (0)
#define PG8_LDB(dst, b, h) do { _Pragma("unroll") for (int n = 0; n < 2; ++n) _Pragma("unroll") for (int k = 0; k < 2; ++k) dst[n][k] = *(const LAS bf16x8*)(lds + PG8_SB(b, h) + boff + n * 2048 + k * 1024); } while (0)
#define PG8_MMA(ai, bj, At, Bt) do { __builtin_amdgcn_s_setprio(1); _Pragma("unroll") for (int m = 0; m < 4; ++m) _Pragma("unroll") for (int n = 0; n < 2; ++n) _Pragma("unroll") for (int k = 0; k < 2; ++k) \
        acc[ai][bj][m][n] = __builtin_amdgcn_mfma_f32_16x16x32_bf16(Bt[n][k], At[m][k], acc[ai][bj][m][n], 0, 0, 0); __builtin_amdgcn_s_setprio(0); } while (0)
#define PG8_WAIT_V(n) asm volatile("s_waitcnt vmcnt(" #n ")" ::: "memory")
#define PG8_WAIT_L(n) asm volatile("s_waitcnt lgkmcnt(" #n ")" ::: "memory")
#define PG8_BAR __builtin_amdgcn_s_barrier()
#define PG8_SCHED __builtin_amdgcn_sched_barrier(0)
    Unit cur, nxt; int ui = 0;
    if (!S.next(0, cur)) return;
    f32x4 acc[2][2][4][2];
#pragma unroll
    for (int a = 0; a < 2; ++a)
#pragma unroll
        for (int b = 0; b < 2; ++b)
#pragma unroll
            for (int m = 0; m < 4; ++m)
#pragma unroll
                for (int n = 0; n < 2; ++n) acc[a][b][m][n] = (f32x4){0.f, 0.f, 0.f, 0.f};
    bf16x8 At[4][2], B0[2][2], B1[2][2];
    const char* cA = (const char*)g.A + cur.aoff; const char* cB = (const char*)g.Bt + cur.boff;
    S.a_ready(cur);
    if constexpr (Sched::GATHER) { PG8_GIDX(cG, cur); Unit n1; if (S.next(1, n1)) PG8_GIDX(nG, n1); else PG8_GIDX(nG, cur); PG8_GOFF(cG); PG8_GOFF(nG); }
    PG8_STAGE(PG8_SB(0, 0), cB, voffB); PG8_STAGE(PG8_SB(0, 1), cB + hstep, voffB);
    if constexpr (Sched::GATHER) { PG8_STAGE_G(PG8_SA(0, 0), 0, cG[0][0], cG[0][1]); PG8_STAGE_G(PG8_SA(0, 1), 0, cG[1][0], cG[1][1]); }
    else { PG8_STAGE(PG8_SA(0, 0), cA, voffA); PG8_STAGE(PG8_SA(0, 1), cA + hstep, voffA); }
    if (wr == 1) PG8_BAR;
    PG8_WAIT_V(2); PG8_BAR;
    PG8_STAGE(PG8_SB(1, 0), cB + kstep, voffB);
    if constexpr (Sched::GATHER) PG8_STAGE_G(PG8_SA(1, 0), kstep, cG[0][0], cG[0][1]); else PG8_STAGE(PG8_SA(1, 0), cA + kstep, voffA);
    PG8_STAGE(PG8_SB(1, 1), cB + hstep + kstep, voffB);
    PG8_WAIT_V(6); PG8_BAR;
    for (;;) {
        const bool has_next = S.next(ui + 1, nxt);
        const char* nA = has_next ? (const char*)g.A + nxt.aoff : cA; const char* nB = has_next ? (const char*)g.Bt + nxt.boff : cB;
        for (int t = 0; t < nt; t += 2) {
            const bool last = (t == nt - 2);
            const char* a1 = cA + (size_t)(t + 1) * kstep;
            const char* a2 = last ? nA : cA + (size_t)(t + 2) * kstep; const char* b2 = last ? nB : cB + (size_t)(t + 2) * kstep;
            const char* a3 = a2 + kstep; const char* b3 = b2 + kstep;
            if (last && has_next) S.a_ready(nxt);
            const size_t ko1 = (size_t)(t + 1) * kstep, ko2 = last ? 0 : (size_t)(t + 2) * kstep, ko3 = ko2 + kstep; const bool un = last && has_next;
            PG8_LDB(B0, 0, 0); PG8_LDB(B1, 0, 1); PG8_SCHED; PG8_LDA(At, 0, 0);
            if constexpr (Sched::GATHER) PG8_STAGE_G(PG8_SA(1, 1), ko1, cG[1][0], cG[1][1]); else PG8_STAGE(PG8_SA(1, 1), a1 + hstep, voffA);
            PG8_WAIT_V(8); PG8_WAIT_L(0); PG8_BAR; PG8_MMA(0, 0, At, B0); PG8_MMA(0, 1, At, B1); PG8_BAR; PG8_SCHED;
            PG8_LDA(At, 0, 1); PG8_STAGE(PG8_SB(0, 0), b2, voffB); PG8_STAGE(PG8_SB(0, 1), b2 + hstep, voffB);
            if constexpr (Sched::GATHER) PG8_STAGE_G(PG8_SA(0, 0), ko2, un ? nG[0][0] : cG[0][0], un ? nG[0][1] : cG[0][1]); else PG8_STAGE(PG8_SA(0, 0), a2, voffA);
            PG8_WAIT_V(8); PG8_WAIT_L(0); PG8_BAR; PG8_MMA(1, 0, At, B0); PG8_MMA(1, 1, At, B1); PG8_BAR; PG8_SCHED;
            PG8_LDB(B0, 1, 0); PG8_LDB(B1, 1, 1); PG8_SCHED; PG8_LDA(At, 1, 0);
            if constexpr (Sched::GATHER) PG8_STAGE_G(PG8_SA(0, 1), ko2, un ? nG[1][0] : cG[1][0], un ? nG[1][1] : cG[1][1]); else PG8_STAGE(PG8_SA(0, 1), a2 + hstep, voffA);
            PG8_WAIT_V(8); PG8_WAIT_L(0); PG8_BAR; PG8_MMA(0, 0, At, B0); PG8_MMA(0, 1, At, B1); PG8_BAR; PG8_SCHED;
            PG8_LDA(At, 1, 1); PG8_STAGE(PG8_SB(1, 0), b3, voffB); PG8_STAGE(PG8_SB(1, 1), b3 + hstep, voffB);
            if constexpr (Sched::GATHER) PG8_STAGE_G(PG8_SA(1, 0), ko3, un ? nG[0][0] : cG[0][0], un ? nG[0][1] : cG[0][1]); else PG8_STAGE(PG8_SA(1, 0), a3, voffA);
            PG8_WAIT_V(8); PG8_WAIT_L(0); PG8_BAR; PG8_MMA(1, 0, At, B0); PG8_MMA(1, 1, At, B1); PG8_BAR; PG8_SCHED;
        }
        if (wr == 0) PG8_BAR;
        unsigned xG[2][2];
        if constexpr (Sched::GATHER) { Unit n2; if (S.next(ui + 2, n2)) PG8_GIDX(xG, n2); else PG8_GIDX(xG, cur); }
        E(acc, cur, wr, wc, fr, fq); S.done(cur);
        if constexpr (Sched::GATHER) { PG8_GOFF(xG);
#pragma unroll
            for (int h_ = 0; h_ < 2; ++h_)
#pragma unroll
                for (int i_ = 0; i_ < 2; ++i_) { cG[h_][i_] = nG[h_][i_]; nG[h_][i_] = xG[h_][i_]; } }
        if (!has_next) break;
#pragma unroll
        for (int a = 0; a < 2; ++a)
#pragma unroll
            for (int b = 0; b < 2; ++b)
#pragma unroll
                for (int m = 0; m < 4; ++m)
#pragma unroll
                    for (int n = 0; n < 2; ++n) acc[a][b][m][n] = (f32x4){0.f, 0.f, 0.f, 0.f};
        cur = nxt; cA = nA; cB = nB; ++ui;
        if (wr == 1) PG8_BAR;
    }
    PG8_WAIT_V(0);
    PG8_BAR;
#undef PG8_SA
#undef PG8_SB
#undef PG8_STAGE
#undef PG8_GIDX
#undef PG8_GOFF
#undef PG8_STAGE_G
#undef PG8_LDA
#undef PG8_LDB
#undef PG8_MMA
#undef PG8_WAIT_V
#undef PG8_WAIT_L
#undef PG8_BAR
#undef PG8_SCHED
}

struct EpiProj {
    static constexpr bool PERM = true;
    bf16_t *pa, *pq; const float* rstd;
    __device__ __forceinline__ void operator()(const f32x4 (&acc)[2][2][4][2], const Unit& u, int wr, int wc, int fr, int fq) const {
        const int row0 = u.pm * BM + wr * 64 + fr; int colt = u.pn * BM; bf16_t* base = pa;
        if (colt >= 1536) { base = pq; colt -= 1536; }
        const int col0 = colt + wc * 32 + 8 * fq;
#pragma unroll
        for (int ai = 0; ai < 2; ++ai)
#pragma unroll
            for (int m = 0; m < 4; ++m) { const int row = row0 + ai * HALF + m * 16; const float sc = rstd[row];
                const int orow = row + TREAL + (row >= SEQ ? (LP - SEQ) : 0);
                bf16_t* rowp = base + (size_t)orow * 1536 + col0;
#pragma unroll
                for (int bj = 0; bj < 2; ++bj) { const f32x4 v0 = acc[ai][bj][m][0] * sc, v1 = acc[ai][bj][m][1] * sc;
                    u32x4 w; w.x = cvt_pk_bf16(v0[0], v0[1]); w.y = cvt_pk_bf16(v0[2], v0[3]); w.z = cvt_pk_bf16(v1[0], v1[1]); w.w = cvt_pk_bf16(v1[2], v1[3]);
                    *(u32x4*)(rowp + bj * HALF) = w; } }
    }
};
struct EpiZ {
    static constexpr bool PERM = true;
    bf16_t* pz; const float* rstd;
    __device__ __forceinline__ void operator()(const f32x4 (&acc)[2][2][4][2], const Unit& u, int wr, int wc, int fr, int fq) const {
        const int row0 = u.pm * BM + wr * 64 + fr, col0 = u.pn * BM + wc * 32 + 8 * fq;
#pragma unroll
        for (int ai = 0; ai < 2; ++ai)
#pragma unroll
            for (int m = 0; m < 4; ++m) { const int row = row0 + ai * HALF + m * 16; const float sc = rstd[row];
                bf16_t* rowp = pz + (size_t)row * 512 + col0;
#pragma unroll
                for (int bj = 0; bj < 2; ++bj) { const f32x4 v0 = acc[ai][bj][m][0] * sc, v1 = acc[ai][bj][m][1] * sc;
                    u32x4 w; w.x = cvt_pk_bf16(v0[0], v0[1]); w.y = cvt_pk_bf16(v0[2], v0[3]); w.z = cvt_pk_bf16(v1[0], v1[1]); w.w = cvt_pk_bf16(v1[2], v1[3]);
                    *(u32x4*)(rowp + bj * HALF) = w; } }
    }
};
struct ZOrder {
    static constexpr bool GATHER = false;
    int j, nw;
    __device__ bool next(int i, Unit& o) const { const int L = j + i * nw; if (L >= 128) return false;
        o.pm = L >> 1; o.pn = L & 1; o.aoff = (unsigned)(L >> 1) * (256u * DM * 2u); o.boff = (unsigned)(12 + (L & 1)) * (256u * DM * 2u); return true; }
    __device__ __forceinline__ void a_ready(const Unit&) const {}
    __device__ __forceinline__ void done(const Unit&) const {}
};
struct EpiRes {
    static constexpr bool PERM = true;
    const bf16_t* xb; bf16_t* h1;
    __device__ __forceinline__ void operator()(const f32x4 (&acc)[2][2][4][2], const Unit& u, int wr, int wc, int fr, int fq) const {
        const int row0 = u.pm * BM + wr * 64 + fr, col0 = u.pn * BM + wc * 32 + 8 * fq;
        u32x4 xr[2][4][2];
#pragma unroll
        for (int ai = 0; ai < 2; ++ai)
#pragma unroll
            for (int m = 0; m < 4; ++m)
#pragma unroll
                for (int bj = 0; bj < 2; ++bj) xr[ai][m][bj] = __builtin_nontemporal_load((const u32x4*)(xb + (size_t)(row0 + ai * HALF + m * 16) * DM + col0 + bj * HALF));
#pragma unroll
        for (int ai = 0; ai < 2; ++ai)
#pragma unroll
            for (int m = 0; m < 4; ++m) { const size_t off = (size_t)(row0 + ai * HALF + m * 16) * DM + col0;
#pragma unroll
                for (int bj = 0; bj < 2; ++bj) { const u32x4 x4 = xr[ai][m][bj];
                    const f32x4 v0 = (f32x4){bf_lo(x4.x), bf_hi(x4.x), bf_lo(x4.y), bf_hi(x4.y)} + acc[ai][bj][m][0], v1 = (f32x4){bf_lo(x4.z), bf_hi(x4.z), bf_lo(x4.w), bf_hi(x4.w)} + acc[ai][bj][m][1];
                    u32x4 w; w.x = cvt_pk_bf16(v0[0], v0[1]); w.y = cvt_pk_bf16(v0[2], v0[3]); w.z = cvt_pk_bf16(v1[0], v1[1]); w.w = cvt_pk_bf16(v1[2], v1[3]);
                    *(u32x4*)(h1 + off + bj * HALF) = w; } }
    }
};
struct EpiGU {
    static constexpr bool PERM = true;
    bf16_t* hid; const float* rsc; const LAS int* tvalid;
    __device__ __forceinline__ void operator()(const f32x4 (&acc)[2][2][4][2], const Unit& u, int wr, int wc, int fr, int fq) const {
        const __amdgpu_buffer_rsrc_t rs = __builtin_amdgcn_make_buffer_rsrc((void*)hid, 0, ROWS_CAP * DEXP * 2, 0x00020000);
        const int row0 = u.pm * BM + wr * 64 + fr, col0 = u.pn * HALF + wc * 32 + 8 * fq, nvalid = tvalid[u.pm] + u.pm * BM;
#pragma unroll
        for (int ai = 0; ai < 2; ++ai)
#pragma unroll
            for (int m = 0; m < 4; ++m) { const int row = row0 + ai * HALF + m * 16; if (row >= nvalid) continue; const float sc = rsc[row];
                float h[8];
#pragma unroll
                for (int n = 0; n < 2; ++n)
#pragma unroll
                    for (int i = 0; i < 4; ++i) { const float gt = acc[ai][0][m][n][i] * sc, up = acc[ai][1][m][n][i] * sc; h[4 * n + i] = silu_f(gt) * up; }
                u32x4 w; w.x = cvt_pk_bf16(h[0], h[1]); w.y = cvt_pk_bf16(h[2], h[3]); w.z = cvt_pk_bf16(h[4], h[5]); w.w = cvt_pk_bf16(h[6], h[7]);
                __builtin_amdgcn_raw_buffer_store_b128(w, rs, (row * DEXP + col0) * 2, 0, 16); }
    }
};
struct EpiBf16 {
    static constexpr bool PERM = true;
    bf16_t* O; int ldc; const LAS int* tvalid;
    __device__ __forceinline__ void operator()(const f32x4 (&acc)[2][2][4][2], const Unit& u, int wr, int wc, int fr, int fq) const {
        const int row0 = u.pm * BM + wr * 64 + fr, col0 = u.pn * BM + wc * 32 + 8 * fq, nvalid = tvalid[u.pm] + u.pm * BM;
#pragma unroll
        for (int ai = 0; ai < 2; ++ai)
#pragma unroll
            for (int m = 0; m < 4; ++m) { if (row0 + ai * HALF + m * 16 >= nvalid) continue; bf16_t* rowp = O + (size_t)(row0 + ai * HALF + m * 16) * ldc + col0;
#pragma unroll
                for (int bj = 0; bj < 2; ++bj) { const f32x4 v0 = acc[ai][bj][m][0], v1 = acc[ai][bj][m][1];
                    u32x4 w; w.x = cvt_pk_bf16(v0[0], v0[1]); w.y = cvt_pk_bf16(v0[2], v0[3]); w.z = cvt_pk_bf16(v1[0], v1[1]); w.w = cvt_pk_bf16(v1[2], v1[3]);
                    *(u32x4*)(rowp + bj * HALF) = w; } }
    }
};
}

struct Args { const float* in[20]; float* out; unsigned char* ws; int ph_lo, ph_hi; };
enum { I_X = 0, I_META, I_MIXNW, I_WIN, I_CMW, I_CMNW, I_QKVCW, I_ALOG, I_DTB, I_GDNNW, I_WOUT, I_FFNNW, I_WGRP, I_BGRP, I_WRT, I_BRT, I_WG, I_WU, I_WD, I_FINNW };

struct Frame {
    LAS unsigned char* lds;
    unsigned char* ws; unsigned char* dob;
    int tid, lane, wave, G, vcu;
};

constexpr int TR_SCR = 64 * 65 * 4;
template <bool NT_STORE> __device__ __forceinline__ void transpose_tile64(const float* W, int ldn, int Kout, bf16_t* WT, const float* kscale, LAS float* scr, int k0, int n0, int outrow0, int lane) {
    const int kr = lane >> 4, c4 = lane & 15;
    f32x4 v[16];
#pragma unroll
    for (int i = 0; i < 16; ++i) v[i] = __builtin_nontemporal_load((const f32x4*)(W + (size_t)(k0 + 4 * i + kr) * ldn + n0 + 4 * c4));
#pragma unroll
    for (int i = 0; i < 16; ++i) { LAS float* d = scr + (4 * i + kr) * 65 + 4 * c4; d[0] = v[i][0]; d[1] = v[i][1]; d[2] = v[i][2]; d[3] = v[i][3]; }
    LDS_WAIT(); asm volatile("" ::: "memory");
    const int kc = lane & 7, nr = lane >> 3;
    float sc[8];
#pragma unroll
    for (int i = 0; i < 8; ++i) sc[i] = kscale ? kscale[k0 + 8 * kc + i] : 1.f;
#pragma unroll
    for (int j = 0; j < 8; ++j) { const int n = nr + 8 * j; const LAS float* t = scr + (8 * kc) * 65 + n;
        u32x4 o; o.x = cvt_pk_bf16(t[0] * sc[0], t[65] * sc[1]); o.y = cvt_pk_bf16(t[130] * sc[2], t[195] * sc[3]); o.z = cvt_pk_bf16(t[260] * sc[4], t[325] * sc[5]); o.w = cvt_pk_bf16(t[390] * sc[6], t[455] * sc[7]);
        if constexpr (NT_STORE) __builtin_nontemporal_store(o, (u32x4*)(WT + (size_t)(outrow0 + n) * Kout + k0 + 8 * kc));
        else *(u32x4*)(WT + (size_t)(outrow0 + n) * Kout + k0 + 8 * kc) = o; }
    LDS_WAIT(); asm volatile("" ::: "memory");
}

__device__ __forceinline__ void p0_prologue(Frame& F, const Args& a) {
    const int gw = F.vcu * 8 + F.wave, NGW = F.G * 8;
    LAS float* scr = (LAS float*)(F.lds + F.wave * TR_SCR);
    LAS float* wab = (LAS float*)(F.lds);
    const float* w_in = a.in[I_WIN]; const float* mixnw = a.in[I_MIXNW];
    bf16_t* WinT = (bf16_t*)(F.ws + WS_WIN); bf16_t* WoutT = (bf16_t*)(F.ws + WS_WOUT);
    constexpr int I_IN = 16 * 56, I_OUT = 16 * 16, I_WR = 32 * 3 * 2;
    for (int it = gw; it < I_IN + I_OUT + I_WR; it += NGW) {
        int r = it;
        if (r < I_IN) { transpose_tile64<false>(w_in, PROJ_LD, DM, WinT, mixnw, scr, 64 * (r / 56), 64 * (r % 56), 64 * (r % 56), F.lane); continue; } r -= I_IN;
        if (r < I_OUT) { transpose_tile64<false>(a.in[I_WOUT], DM, DM, WoutT, nullptr, scr, 64 * (r / 16), 64 * (r % 16), 64 * (r % 16), F.lane); continue; } r -= I_OUT;
        {
            const int ks = r / 6, nt = (r % 6) >> 1, hl = r & 1, j = F.lane & 15, q = F.lane >> 4, c = 16 * nt + j; unsigned pk[4];
#pragma unroll
            for (int jp = 0; jp < 4; ++jp) { float wv[2];
#pragma unroll
                for (int t = 0; t < 2; ++t) { const int k = 32 * ks + 8 * q + 2 * jp + t; float w = 0.f;
                    if (c < 4) w = a.in[I_WGRP][k * 4 + c]; else if (c < 36) w = a.in[I_WRT][k * 32 + (c - 4)];
                    w *= a.in[I_FFNNW][k];
                    const float hi = bf_lo(cvt_pk_bf16(w, 0.f) & 0xffffu); wv[t] = hl ? (w - hi) : hi; }
                pk[jp] = cvt_pk_bf16(wv[0], wv[1]); }
            ((u32x4*)(F.ws + WS_WRF))[(size_t)r * 64 + F.lane] = (u32x4){pk[0], pk[1], pk[2], pk[3]};
        }
    }
    __syncthreads();
    if (F.vcu < 192) {
        const int n0 = 16 * F.vcu, l15 = F.lane & 15, q = F.lane >> 4, kb = 128 * F.wave;
        const float* mrow = a.in[I_META] + (size_t)l15 * DM + kb + q; const float* wcol = w_in + (size_t)(kb + q) * PROJ_LD + n0 + l15;
        float av[32], bv[32];
#pragma unroll
        for (int s4 = 0; s4 < 32; ++s4) { av[s4] = mrow[4 * s4]; bv[s4] = wcol[(size_t)(4 * s4) * PROJ_LD] * mixnw[kb + 4 * s4 + q]; }
        f32x4 acc = (f32x4){0.f, 0.f, 0.f, 0.f}; float ssq = 0.f;
#pragma unroll
        for (int s4 = 0; s4 < 32; ++s4) { ssq += av[s4] * av[s4]; acc = __builtin_amdgcn_mfma_f32_16x16x4f32(av[s4], bv[s4], acc, 0, 0, 0); }
        ssq += __shfl_xor(ssq, 16); ssq += __shfl_xor(ssq, 32);
        LAS float* red = (LAS float*)(F.lds);
#pragma unroll
        for (int rr = 0; rr < 4; ++rr) red[(F.wave * 16 + 4 * q + rr) * 17 + l15] = acc[rr];
        if (q == 0) red[8 * 16 * 17 + F.wave * 16 + l15] = ssq;
        __syncthreads();
        if (F.tid < 256) { const int i = F.tid >> 4, j = F.tid & 15; float v = 0.f, sq = 0.f;
#pragma unroll
            for (int w = 0; w < 8; ++w) { v += red[(w * 16 + i) * 17 + j]; sq += red[8 * 16 * 17 + w * 16 + i]; }
            v *= rsqrtf(sq * (1.f / DM) + EPS);
            bf16_t* dst = (n0 < 1536 ? (bf16_t*)(F.ws + WS_PA) + n0 : (bf16_t*)(F.ws + WS_PQ) + (n0 - 1536)) + j;
            const bf16_t hb = (bf16_t)(cvt_pk_bf16(v, 0.f) & 0xffffu);
            dst[(size_t)(TPAD + i) * 1536] = hb; dst[(size_t)(LP + TPAD + i) * 1536] = hb; }
        __syncthreads();
    }
    for (int i = F.tid; i < 8 * 1024; i += 512) { const int k = i >> 3, c = i & 7; wab[c * 1024 + k] = w_in[(size_t)k * PROJ_LD + NPROJ + c] * mixnw[k]; }
    __syncthreads();
    bf16_t* xb = (bf16_t*)(F.ws + WS_XB); float* rstd1 = (float*)(F.ws + WS_RSTD1); float* gb = (float*)(F.ws + WS_GB);
#define P0_LOAD_ROW(rr, dst) do { const int b_ = (rr) / LP, t_ = (rr) % LP; \
        if (t_ >= TPAD) { const float* src_ = t_ < TREAL ? a.in[I_META] + (size_t)(t_ - TPAD) * DM : a.in[I_X] + ((size_t)b_ * SEQ + (t_ - TREAL)) * DM; \
            _Pragma("unroll") for (int j = 0; j < 4; ++j) dst[j] = __builtin_nontemporal_load((const f32x4*)src_ + 64 * j + F.lane); } \
        else { _Pragma("unroll") for (int j = 0; j < 4; ++j) dst[j] = (f32x4){0.f, 0.f, 0.f, 0.f}; } } while (0)
    f32x4 vnx[4];
    if (gw < MR) P0_LOAD_ROW(gw, vnx);
    for (int r = gw; r < MR; r += NGW) {
        const int t = r % LP;
        f32x4 v[4];
#pragma unroll
        for (int j = 0; j < 4; ++j) v[j] = vnx[j];
        if (r + NGW < MR) P0_LOAD_ROW(r + NGW, vnx);
        float ss = 0.f;
#pragma unroll
        for (int j = 0; j < 4; ++j) ss += (v[j][0] * v[j][0] + v[j][1] * v[j][1]) + (v[j][2] * v[j][2] + v[j][3] * v[j][3]);
        ss = wave_sum(ss);
        const float rstd = rsqrtf(ss * (1.f / DM) + EPS);
        if (t >= TREAL) {
            const int m = (r / LP) * SEQ + (t - TREAL);
            u32x2* o8 = (u32x2*)(xb + (size_t)m * DM);
#pragma unroll
            for (int j = 0; j < 4; ++j) { u32x2 w; w.x = cvt_pk_bf16(v[j][0], v[j][1]); w.y = cvt_pk_bf16(v[j][2], v[j][3]); o8[64 * j + F.lane] = w; }
            if (F.lane == 0) rstd1[m] = rstd;
        } else if (t < TPAD) {
            u32x4* za = (u32x4*)((bf16_t*)(F.ws + WS_PA) + (size_t)r * 1536); u32x4* zq = (u32x4*)((bf16_t*)(F.ws + WS_PQ) + (size_t)r * 1536);
#pragma unroll
            for (int j = 0; j < 3; ++j) { za[64 * j + F.lane] = (u32x4){0u, 0u, 0u, 0u}; zq[64 * j + F.lane] = (u32x4){0u, 0u, 0u, 0u}; }
        }
        float ab[8];
#pragma unroll
        for (int c = 0; c < 8; ++c) { float s = 0.f;
#pragma unroll
            for (int j = 0; j < 4; ++j) { const f32x4 w = *(const LAS f32x4*)(wab + c * 1024 + 256 * j + 4 * F.lane); s += (v[j][0] * w[0] + v[j][1] * w[1]) + (v[j][2] * w[2] + v[j][3] * w[3]); }
            ab[c] = wave_sum(s); }
        if (F.lane < 4) { const int h = F.lane;
            float av = ab[0], bv = ab[4];
            if (h == 1) { av = ab[1]; bv = ab[5]; } else if (h == 2) { av = ab[2]; bv = ab[6]; } else if (h == 3) { av = ab[3]; bv = ab[7]; }
            av *= rstd; bv *= rstd;
            const float z = av + a.in[I_DTB][h];
            const float sp = fmaxf(z, 0.f) + log1pf(expf(-fabsf(z)));
            float g = -expf(a.in[I_ALOG][h]) * sp, be = 1.f / (1.f + expf(-bv));
            if (t < TPAD) { g = 0.f; be = 0.f; }
            gb[(size_t)r * 8 + h] = g; gb[(size_t)r * 8 + 4 + h] = be; }
    }
#undef P0_LOAD_ROW
}

__device__ __forceinline__ void unpack8(const u32x4 w, float (&f)[8]) { f[0] = bf_lo(w.x); f[1] = bf_hi(w.x); f[2] = bf_lo(w.y); f[3] = bf_hi(w.y); f[4] = bf_lo(w.z); f[5] = bf_hi(w.z); f[6] = bf_lo(w.w); f[7] = bf_hi(w.w); }
__device__ __forceinline__ void p2_mixer_a(Frame& F, const Args& a) {
    if (F.G > 16 && F.vcu < 8) return;
    const int skip = F.G > 16 ? 8 : 0;
    const int gw = (F.vcu - skip) * 8 + F.wave, NGW = (F.G - skip) * 8;
    const bf16_t* PA = (const bf16_t*)(F.ws + WS_PA); bf16_t* YC = (bf16_t*)(F.ws + WS_YCAT);
    const int c0 = 8 * F.lane;
    float w0[8], w1[8], w2[8], nw[8];
#pragma unroll
    for (int i = 0; i < 8; ++i) { w0[i] = a.in[I_CMW][c0 + i]; w1[i] = a.in[I_CMW][512 + c0 + i]; w2[i] = a.in[I_CMW][1024 + c0 + i]; nw[i] = a.in[I_CMNW][c0 + i]; }
    for (int uu = gw; uu < MT / 8; uu += NGW) {
        const int b = uu / (SEQ / 8), s0 = (uu % (SEQ / 8)) * 8;
        const size_t r0 = (size_t)b * LP + s0 + TREAL;
        u32x4 gcr[10], uvr[10], gbr[8];
#pragma unroll
        for (int w = 0; w < 10; ++w) { gcr[w] = __builtin_nontemporal_load((const u32x4*)(PA + (r0 - 2 + w) * 1536 + 512 + c0)); uvr[w] = __builtin_nontemporal_load((const u32x4*)(PA + (r0 - 2 + w) * 1536 + 1024 + c0)); }
#pragma unroll
        for (int w = 0; w < 8; ++w) gbr[w] = __builtin_nontemporal_load((const u32x4*)(PA + (r0 + w) * 1536 + c0));
        float p2[8], p1[8];
        { float gc[8], uv[8]; unpack8(gcr[0], gc); unpack8(uvr[0], uv);
#pragma unroll
          for (int i = 0; i < 8; ++i) p2[i] = gc[i] * uv[i];
          unpack8(gcr[1], gc); unpack8(uvr[1], uv);
#pragma unroll
          for (int i = 0; i < 8; ++i) p1[i] = gc[i] * uv[i]; }
#pragma unroll
        for (int rr = 0; rr < 8; ++rr) {
            float gc[8], uv[8], gbv[8], y[8];
            unpack8(gbr[rr], gbv); unpack8(gcr[rr + 2], gc); unpack8(uvr[rr + 2], uv);
            float ss = 0.f;
#pragma unroll
            for (int i = 0; i < 8; ++i) { const float p = gc[i] * uv[i]; y[i] = gbv[i] * (w0[i] * p2[i] + w1[i] * p1[i] + w2[i] * p); p2[i] = p1[i]; p1[i] = p; ss += y[i] * y[i]; }
            ss += __shfl_xor(ss, 1); ss += __shfl_xor(ss, 2); ss += __shfl_xor(ss, 4);
            const float rs = rsqrtf(ss * (1.f / 64.f) + EPS);
            u32x4 w; w.x = cvt_pk_bf16(y[0] * rs * nw[0], y[1] * rs * nw[1]); w.y = cvt_pk_bf16(y[2] * rs * nw[2], y[3] * rs * nw[3]);
            w.z = cvt_pk_bf16(y[4] * rs * nw[4], y[5] * rs * nw[5]); w.w = cvt_pk_bf16(y[6] * rs * nw[6], y[7] * rs * nw[7]);
            *(u32x4*)(YC + ((size_t)b * SEQ + s0 + rr) * DM + c0) = w;
        }
    }
}

constexpr int P3_Q16 = 0, P3_K16 = 16384, P3_RT = 32768, P3_T16 = 65536, P3_LM = 73728, P3_TF = 91136, P3_XS = 108544, P3_GC = 113152, P3_CW = 114176;
static_assert(P3_CW + 4 * 1536 * 4 <= LDSCTL_OFF, "P3 LDS map");
__device__ __forceinline__ int p3_sw(int row, int chunk) { return row * 256 + ((chunk ^ (row & 15)) << 4); }
__device__ __forceinline__ int p3_sw64(int row, int chunk) { return row * 128 + ((chunk ^ ((row >> 1) & 7)) << 4); }
__device__ __forceinline__ float silu_fast(float x) { return x * __builtin_amdgcn_rcpf(1.f + __expf(-x)); }
__device__ __forceinline__ void mm16(f32x4& acc, const LAS float* Ab, int lda, const LAS float* Bb, int ldb, int l15, int q) {
#pragma unroll
    for (int s4 = 0; s4 < 4; ++s4) acc = __builtin_amdgcn_mfma_f32_16x16x4f32(Ab[l15 * lda + 4 * s4 + q], Bb[(4 * s4 + q) * ldb + l15], acc, 0, 0, 0);
}
__device__ __forceinline__ void p3_prefetch(Frame& F, const Args& a, int unit, float& pg, float& pbe, u32x4 (&xp)[11]) {
    const int bh = unit / NCHUNK, n = unit % NCHUNK, b = bh >> 2, h = bh & 3, t0 = 64 * n;
    const size_t rbase = (size_t)b * LP + t0;
    const float* gb = (const float*)(F.ws + WS_GB);
    if (F.tid < 64) { pg = gb[(rbase + F.tid) * 8 + h]; pbe = gb[(rbase + F.tid) * 8 + 4 + h]; }
    if (F.tid < 384) {
        const int part = F.tid >> 7, rb = (F.tid >> 4) & 7, ch = F.tid & 15, dk0 = ch * 8;
        const int col = part * 512 + h * 128 + dk0;
        const bf16_t* PQ = (const bf16_t*)(F.ws + WS_PQ);
#pragma unroll
        for (int w = 0; w < 11; ++w) { const int tt = t0 + 8 * rb - 3 + w;
            if (tt >= 0) xp[w] = __builtin_nontemporal_load((const u32x4*)(PQ + ((size_t)b * LP + tt) * 1536 + col)); else xp[w] = (u32x4){0u, 0u, 0u, 0u}; }
    }
}
__device__ __forceinline__ void p3_phase(Frame& F, const Args& a) {
  float pg = 0.f, pbe = 0.f; u32x4 xp[11];
  int unit = F.vcu;
  if (unit < NUNIT_GDN) p3_prefetch(F, a, unit, pg, pbe, xp);
  { LAS float* cw0 = (LAS float*)(F.lds + P3_CW);
    for (int i = F.tid; i < 4 * 1536; i += 512) cw0[i] = a.in[I_QKVCW][i]; }
  __syncthreads();
  for (; unit < NUNIT_GDN; unit += F.G) {
    int vzu; asm volatile("v_mov_b32 %0, 0" : "=v"(vzu));
    const int tid_o = F.tid + vzu, lane_o = tid_o & 63, l15 = lane_o & 15, q = lane_o >> 4;
    LAS unsigned char* L = F.lds + vzu;
    LAS float* gcs = (LAS float*)(L + P3_GC);
    LAS float* Lm = (LAS float*)(L + P3_LM);
    LAS float* Tf = (LAS float*)(L + P3_TF);
    LAS float* Xs = (LAS float*)(L + P3_XS);
    LAS float* cwl = (LAS float*)(L + P3_CW);
    const int bh = unit / NCHUNK, n = unit % NCHUNK, h = bh & 3, t0 = 64 * n;
    unsigned char* gW = F.dob + DO_W + (size_t)unit * 16384; unsigned char* gU = F.dob + DO_U + (size_t)unit * 16384; unsigned char* gQG = F.dob + DO_QG + (size_t)unit * 16384;
    unsigned char* gKD = F.ws + WS_KD + (size_t)unit * 16384; unsigned char* gIN = F.ws + WS_IN + (size_t)unit * 8192;
    if (F.tid < 64) {
        float g = pg; const float be = pbe;
#pragma unroll
        for (int o = 1; o < 64; o <<= 1) { const float t = __shfl_up(g, o); if (F.lane >= o) g += t; }
        const float gl = __shfl(g, 63);
        gcs[F.tid] = g; gcs[64 + F.tid] = be; gcs[128 + F.tid] = __expf(g); gcs[192 + F.tid] = __expf(gl - g);
        if (F.tid == 63) ((float*)(F.ws + WS_ALAST))[unit] = __expf(g);
    }
    __syncthreads();
    if (F.tid < 384) {
        const int part = F.wave >> 1, rb = (tid_o >> 4) & 7, ch = tid_o & 15, dk0 = ch * 8;
        const int col = part * 512 + h * 128 + dk0;
        float cw[4][8];
#pragma unroll
        for (int j = 0; j < 4; ++j) { const f32x4 c0 = *(const LAS f32x4*)(cwl + j * 1536 + col), c1 = *(const LAS f32x4*)(cwl + j * 1536 + col + 4);
            cw[j][0] = c0[0]; cw[j][1] = c0[1]; cw[j][2] = c0[2]; cw[j][3] = c0[3]; cw[j][4] = c1[0]; cw[j][5] = c1[1]; cw[j][6] = c1[2]; cw[j][7] = c1[3]; }
        float xw[4][8];
        unpack8(xp[0], xw[0]); unpack8(xp[1], xw[1]); unpack8(xp[2], xw[2]);
        unsigned kdp[4][8], rtp[4][8]; float kde[8], rte[8];
        unsigned char* qgb; { const int mt = rb >> 1, ks = dk0 >> 5, r32 = dk0 & 31, half = r32 >> 4, qq = (r32 & 15) >> 2;
            qgb = gQG + ((size_t)((mt * 4 + ks) * 64 + 8 * (rb & 1)) << 4) + half * 8 + (qq << 8); }
#pragma unroll
        for (int rr = 0; rr < 8; ++rr) {
            const int row = 8 * rb + rr; const bool valid = (t0 + row) >= TPAD;
            float o[8]; float ss = 0.f;
            unpack8(xp[rr + 3], xw[(rr + 3) & 3]);
#pragma unroll
            for (int i = 0; i < 8; ++i) { const float c = (cw[0][i] * xw[rr & 3][i] + cw[1][i] * xw[(rr + 1) & 3][i]) + (cw[2][i] * xw[(rr + 2) & 3][i] + cw[3][i] * xw[(rr + 3) & 3][i]); o[i] = silu_fast(c); ss += o[i] * o[i]; }
            const float be = gcs[64 + row], eg = gcs[128 + row], ekd = gcs[192 + row];
            if (part < 2) {
                ss += __shfl_xor(ss, 1); ss += __shfl_xor(ss, 2); ss += __shfl_xor(ss, 4); ss += __shfl_xor(ss, 8);
                float rs = rsqrtf(ss + EPS); if (part == 0) rs *= 0.08838834764831845f; if (!valid) rs = 0.f;
#pragma unroll
                for (int i = 0; i < 8; ++i) o[i] *= rs;
                u32x4 w; w.x = cvt_pk_bf16(o[0], o[1]); w.y = cvt_pk_bf16(o[2], o[3]); w.z = cvt_pk_bf16(o[4], o[5]); w.w = cvt_pk_bf16(o[6], o[7]);
                *(LAS u32x4*)(L + (part == 0 ? P3_Q16 : P3_K16) + p3_sw(row, ch)) = w;
                if (part == 0) {
                    u32x2 p0, p1; p0.x = cvt_pk_bf16(o[0] * eg, o[1] * eg); p0.y = cvt_pk_bf16(o[2] * eg, o[3] * eg); p1.x = cvt_pk_bf16(o[4] * eg, o[5] * eg); p1.y = cvt_pk_bf16(o[6] * eg, o[7] * eg);
                    *(u32x2*)(qgb + rr * 16) = p0; *(u32x2*)(qgb + 256 + rr * 16) = p1;
                } else {
                    const float sc = be * eg;
                    if ((rr & 1) == 0) {
#pragma unroll
                        for (int i = 0; i < 8; ++i) { kde[i] = o[i] * ekd; rte[i] = o[i] * sc; }
                    } else {
#pragma unroll
                        for (int i = 0; i < 8; ++i) { kdp[rr >> 1][i] = cvt_pk_bf16(kde[i], o[i] * ekd); rtp[rr >> 1][i] = cvt_pk_bf16(rte[i], o[i] * sc); }
                    }
                }
            } else {
                const float sc = valid ? be : 0.f;
                if ((rr & 1) == 0) {
#pragma unroll
                    for (int i = 0; i < 8; ++i) rte[i] = o[i] * sc;
                } else {
#pragma unroll
                    for (int i = 0; i < 8; ++i) rtp[rr >> 1][i] = cvt_pk_bf16(rte[i], o[i] * sc);
                }
            }
        }
        if (part == 1) {
            const int tb = 8 * rb, ks2 = tb >> 5, r32 = tb & 31, half = r32 >> 4, qq = (r32 & 15) >> 2, dt = ch >> 1;
            unsigned char* kdb = gKD + ((size_t)((dt * 2 + ks2) * 64 + 8 * (ch & 1)) << 4) + half * 8 + (qq << 8);
#pragma unroll
            for (int i = 0; i < 8; ++i) { u32x2 p0, p1; p0.x = kdp[0][i]; p0.y = kdp[1][i]; p1.x = kdp[2][i]; p1.y = kdp[3][i];
                *(u32x2*)(kdb + i * 16) = p0; *(u32x2*)(kdb + 256 + i * 16) = p1; }
        }
        if (part >= 1) {
            const int n0 = (part == 1 ? 128 : 0) + dk0;
#pragma unroll
            for (int i = 0; i < 8; ++i) *(LAS u32x4*)(L + P3_RT + p3_sw64(n0 + i, rb)) = (u32x4){rtp[0][i], rtp[1][i], rtp[2][i], rtp[3][i]};
        }
    }
    __syncthreads();
    {
        const int prod = F.wave >> 2, mt = F.wave & 3;
        bf16x8 af[4];
#pragma unroll
        for (int ks = 0; ks < 4; ++ks) af[ks] = *(const LAS bf16x8*)(L + P3_K16 + p3_sw(16 * mt + l15, 4 * ks + q));
#pragma unroll
        for (int nt = 0; nt < 4; ++nt) {
            f32x4 d = (f32x4){0.f, 0.f, 0.f, 0.f};
#pragma unroll
            for (int ks = 0; ks < 4; ++ks) { const bf16x8 bfr = *(const LAS bf16x8*)(L + (prod == 0 ? P3_K16 : P3_Q16) + p3_sw(16 * nt + l15, 4 * ks + q)); d = __builtin_amdgcn_mfma_f32_16x16x32_bf16(af[ks], bfr, d, 0, 0, 0); }
            const int i = 16 * nt + l15, j0 = 16 * mt + 4 * q; const float gi = gcs[i], bi = gcs[64 + i];
            float v[4];
#pragma unroll
            for (int r = 0; r < 4; ++r) { const int j = j0 + r; const float dec = __expf(fminf(gi - gcs[j], 0.f));
                if (prod == 0) v[r] = (i > j) ? bi * d[r] * dec : 0.f; else v[r] = (i >= j) ? d[r] * dec : 0.f; }
            if (prod == 0) *(LAS f32x4*)(Lm + i * 68 + j0) = (f32x4){v[0], v[1], v[2], v[3]};
            else { u32x2 p; p.x = cvt_pk_bf16(v[0], v[1]); p.y = cvt_pk_bf16(v[2], v[3]);
                *(u32x2*)(gIN + ((size_t)((nt * 2 + (mt >> 1)) * 64 + q * 16 + l15) << 4) + (mt & 1) * 8) = p; }
        }
    }
    { const int un = unit + F.G; if (un < NUNIT_GDN) p3_prefetch(F, a, un, pg, pbe, xp); }
    __syncthreads();
    if (F.wave < 4) {
        const int bb = F.wave; int vz; asm volatile("v_mov_b32 %0, 0" : "=v"(vz));
        const LAS float* Lb = Lm + (16 * bb) * 68 + 16 * bb + vz;
        float av[16]; av[0] = 0.f;
#pragma unroll
        for (int i = 1; i < 16; ++i) { float sacc = -Lb[i * 68 + l15];
#pragma unroll
            for (int jb = 0; jb < (i + 3) / 4; ++jb) { const f32x4 lv = *(const LAS f32x4*)(Lb + i * 68 + 4 * jb);
                if (4 * jb >= 1) sacc -= lv[0] * av[4 * jb]; if (4 * jb + 1 < i) sacc -= lv[1] * av[4 * jb + 1]; if (4 * jb + 2 < i) sacc -= lv[2] * av[4 * jb + 2]; if (4 * jb + 3 < i) sacc -= lv[3] * av[4 * jb + 3]; }
            av[i] = sacc; }
        if (q == 0) {
#pragma unroll
            for (int i = 0; i < 16; ++i) Tf[(16 * bb + i) * 68 + 16 * bb + l15] = av[i] + (i == l15 ? 1.f : 0.f); }
    }
    __syncthreads();
    if (F.wave < 2) {
        const int lo = 2 * F.wave, hi = lo + 1; LAS float* Xp = Xs + F.wave * 16 * 36;
        f32x4 acc = (f32x4){0.f, 0.f, 0.f, 0.f};
        mm16(acc, Lm + (16 * hi) * 68 + 16 * lo, 68, Tf + (16 * lo) * 68 + 16 * lo, 68, l15, q);
#pragma unroll
        for (int r = 0; r < 4; ++r) Xp[(4 * q + r) * 36 + l15] = acc[r];
        LDS_WAIT(); asm volatile("" ::: "memory");
        acc = (f32x4){0.f, 0.f, 0.f, 0.f};
        mm16(acc, Tf + (16 * hi) * 68 + 16 * hi, 68, Xp, 36, l15, q);
#pragma unroll
        for (int r = 0; r < 4; ++r) Tf[(16 * hi + 4 * q + r) * 68 + 16 * lo + l15] = -acc[r];
    }
    __syncthreads();
    if (F.wave < 4) {
        const int bi = F.wave >> 1, bj = F.wave & 1;
        f32x4 acc = (f32x4){0.f, 0.f, 0.f, 0.f};
        if (bj == 0) mm16(acc, Lm + (16 * (2 + bi)) * 68, 68, Tf, 68, l15, q);
        mm16(acc, Lm + (16 * (2 + bi)) * 68 + 16, 68, Tf + 16 * 68 + 16 * bj, 68, l15, q);
#pragma unroll
        for (int r = 0; r < 4; ++r) Xs[(16 * bi + 4 * q + r) * 36 + 16 * bj + l15] = acc[r];
    }
    __syncthreads();
    if (F.wave < 4) {
        const int bi = F.wave >> 1, bj = F.wave & 1;
        f32x4 acc = (f32x4){0.f, 0.f, 0.f, 0.f};
        mm16(acc, Tf + (16 * (2 + bi)) * 68 + 32, 68, Xs + 16 * bj, 36, l15, q);
        if (bi == 1) mm16(acc, Tf + 48 * 68 + 48, 68, Xs + 16 * 36 + 16 * bj, 36, l15, q);
#pragma unroll
        for (int r = 0; r < 4; ++r) Tf[(16 * (2 + bi) + 4 * q + r) * 68 + 16 * bj + l15] = -acc[r];
    }
    __syncthreads();
    {
        const int row = tid_o >> 3, chunk = tid_o & 7;
        u32x4 w = (u32x4){0u, 0u, 0u, 0u};
        if ((chunk >> 1) <= (row >> 4)) { const f32x4 t0v = *(const LAS f32x4*)(Tf + row * 68 + 8 * chunk), t1v = *(const LAS f32x4*)(Tf + row * 68 + 8 * chunk + 4);
            w.x = cvt_pk_bf16(t0v[0], t0v[1]); w.y = cvt_pk_bf16(t0v[2], t0v[3]); w.z = cvt_pk_bf16(t1v[0], t1v[1]); w.w = cvt_pk_bf16(t1v[2], t1v[3]); }
        *(LAS u32x4*)(L + P3_T16 + p3_sw64(row, chunk)) = w;
    }
    __syncthreads();
    {
        const int w8 = F.wave;
        bf16x8 rv[2], rk[2];
#pragma unroll
        for (int k2 = 0; k2 < 2; ++k2) { rv[k2] = *(const LAS bf16x8*)(L + P3_RT + p3_sw64(16 * w8 + l15, 4 * k2 + q)); rk[k2] = *(const LAS bf16x8*)(L + P3_RT + p3_sw64(128 + 16 * w8 + l15, 4 * k2 + q)); }
#pragma unroll
        for (int mt = 0; mt < 4; ++mt) {
            bf16x8 tf[2];
#pragma unroll
            for (int k2 = 0; k2 < 2; ++k2) tf[k2] = *(const LAS bf16x8*)(L + P3_T16 + p3_sw64(16 * mt + l15, 4 * k2 + q));
            f32x4 du = (f32x4){0.f, 0.f, 0.f, 0.f}, dw = (f32x4){0.f, 0.f, 0.f, 0.f};
#pragma unroll
            for (int k2 = 0; k2 < 2; ++k2) { du = __builtin_amdgcn_mfma_f32_16x16x32_bf16(tf[k2], rv[k2], du, 0, 0, 0); dw = __builtin_amdgcn_mfma_f32_16x16x32_bf16(rk[k2], tf[k2], dw, 0, 0, 0); }
            u32x2 pu, pw; pu.x = cvt_pk_bf16(du[0], du[1]); pu.y = cvt_pk_bf16(du[2], du[3]); pw.x = cvt_pk_bf16(-dw[0], -dw[1]); pw.y = cvt_pk_bf16(-dw[2], -dw[3]);
            *(u32x2*)(gU + ((size_t)((w8 * 4 + mt) * 64 + lane_o) << 3)) = pu;
            *(u32x2*)(gW + ((size_t)((mt * 4 + (w8 >> 1)) * 64 + lane_o) << 4) + (w8 & 1) * 8) = pw;
        }
    }
    __syncthreads();
  }
}

__device__ __forceinline__ bf16x8 pack8(const f32x4 a, const f32x4 b) {
    u32x4 w; w.x = cvt_pk_bf16(a[0], a[1]); w.y = cvt_pk_bf16(a[2], a[3]); w.z = cvt_pk_bf16(b[0], b[1]); w.w = cvt_pk_bf16(b[2], b[3]);
    return __builtin_bit_cast(bf16x8, w);
}
__device__ __forceinline__ unsigned lds_ld_u32(unsigned addr) { unsigned v; asm volatile("ds_read_b32 %0, %1\n\ts_waitcnt lgkmcnt(0)" : "=v"(v) : "v"(addr) : "memory"); return v; }
__device__ __forceinline__ void lds_st_u32(unsigned addr, unsigned val) { asm volatile("ds_write_b32 %0, %1" :: "v"(addr), "v"(val) : "memory"); }
template <int J> __device__ __forceinline__ void p4_scan_loader(Frame& F, int bh, int s) {
    constexpr int CNT = J < 4 ? 6 : 5;
    const unsigned ctl = (unsigned)(size_t)(F.lds + SC_CTL);
    for (int n = 0; n < NCHUNK; ++n) {
        if (n >= 4) { unsigned sp = 0; while ((int)lds_ld_u32(ctl + 32) < n - 3) { __builtin_amdgcn_s_sleep(1); if (++sp > (1u << 22)) break; } }
        const size_t unit = (size_t)bh * NCHUNK + n;
        const unsigned char* gw = F.dob + DO_W + unit * 16384 + F.lane * 16;
        const unsigned char* gk = F.ws + WS_KD + unit * 16384 + F.lane * 16;
        const unsigned char* gu = F.dob + DO_U + unit * 16384 + (size_t)s * 2048 + F.lane * 16;
        LAS unsigned char* slot = F.lds + (n & 3) * SC_SLOT;
#pragma unroll
        for (int i = 0; i < CNT; ++i) { constexpr int dummy = 0; (void)dummy; const int p = J + 6 * i;
            const unsigned char* src = p < 16 ? gw + p * 1024 : (p < 32 ? gk + (p - 16) * 1024 : gu + (p - 32) * 1024);
            __builtin_amdgcn_global_load_lds((const unsigned*)src, (LAS unsigned*)(slot + p * 1024), 16, 0, 0); }
        if (n >= 2) { if constexpr (CNT == 6) asm volatile("s_waitcnt vmcnt(12)" ::: "memory"); else asm volatile("s_waitcnt vmcnt(10)" ::: "memory");
            lds_st_u32(ctl + 4 * J, (unsigned)(n - 1)); }
    }
    if constexpr (CNT == 6) asm volatile("s_waitcnt vmcnt(6)" ::: "memory"); else asm volatile("s_waitcnt vmcnt(5)" ::: "memory");
    lds_st_u32(ctl + 4 * J, (unsigned)(NCHUNK - 1));
    asm volatile("s_waitcnt vmcnt(0)" ::: "memory"); lds_st_u32(ctl + 4 * J, (unsigned)NCHUNK);
}
__device__ __forceinline__ void lds_poll6_gt(unsigned addr, int n) {
    unsigned sp = 0;
    for (;;) { u32x4 v; u32x2 w; asm volatile("ds_read_b128 %0, %2\n\tds_read_b64 %1, %2 offset:16\n\ts_waitcnt lgkmcnt(0)" : "=&v"(v), "=&v"(w) : "v"(addr) : "memory");
        const bool ok = (int)v.x > n && (int)v.y > n && (int)v.z > n && (int)v.w > n && (int)w.x > n && (int)w.y > n;
        if (ok || ++sp > (1u << 24)) break; }
}
__device__ __forceinline__ void p4_scan_c(Frame& F, int bh, int s) {
    const unsigned ctl = (unsigned)(size_t)(F.lds + SC_CTL);
    f32x4 S[8]; bf16x8 Sb[4];
#pragma unroll
    for (int i = 0; i < 8; ++i) S[i] = (f32x4){0.f, 0.f, 0.f, 0.f};
#pragma unroll
    for (int i = 0; i < 4; ++i) Sb[i] = (bf16x8){0, 0, 0, 0, 0, 0, 0, 0};
    const float* alast = (const float*)(F.ws + WS_ALAST) + bh * NCHUNK;
    const float ala = alast[F.lane], alb = alast[64 + F.lane], alc = alast[128];
    unsigned char* sfr = F.ws + WS_SFR + ((size_t)bh * NCHUNK * 8 + s) * 4096 + F.lane * 16;
    bf16x8 Wr[16]; f32x4 vn[4];
    lds_poll6_gt(ctl, 0);
#pragma unroll
    for (int f = 0; f < 16; ++f) Wr[f] = *(const LAS bf16x8*)(F.lds + f * 1024 + F.lane * 16);
#pragma unroll
    for (int mt = 0; mt < 4; ++mt) { const u32x2 u = *(const LAS u32x2*)(F.lds + 32768 + mt * 512 + F.lane * 8); vn[mt] = (f32x4){bf_lo(u.x), bf_hi(u.x), bf_lo(u.y), bf_hi(u.y)}; }
    for (int n = 0; n < NCHUNK; ++n) {
        const LAS unsigned char* slot = F.lds + (n & 3) * SC_SLOT + F.lane * 16;
        bf16x8 Kr[16];
#pragma unroll
        for (int f = 0; f < 16; ++f) Kr[f] = *(const LAS bf16x8*)(slot + 16384 + f * 1024);
#pragma unroll
        for (int ks = 0; ks < 4; ++ks)
#pragma unroll
            for (int mt = 0; mt < 4; ++mt) vn[mt] = __builtin_amdgcn_mfma_f32_16x16x32_bf16(Wr[mt * 4 + ks], Sb[ks], vn[mt], 0, 0, 0);
#pragma unroll
        for (int ks = 0; ks < 4; ++ks) *(bf16x8*)(sfr + (size_t)n * 32768 + ks * 1024) = Sb[ks];
        lds_st_u32(ctl + 32, (unsigned)(n + 1));
        bf16x8 Vb[2]; Vb[0] = pack8(vn[0], vn[1]); Vb[1] = pack8(vn[2], vn[3]);
        asm volatile("" : "+v"(Vb[0]), "+v"(Vb[1]));
        const int nn = n + 1 < NCHUNK ? n + 1 : NCHUNK - 1;
        lds_poll6_gt(ctl, nn);
        asm volatile("" :: "v"(Kr[15]), "v"(Kr[14]));
        const LAS unsigned char* nslot = F.lds + (nn & 3) * SC_SLOT;
        u32x2 Ur[4];
#pragma unroll
        for (int mt = 0; mt < 4; ++mt) Ur[mt] = *(const volatile LAS u32x2*)(nslot + 32768 + mt * 512 + F.lane * 8);
#pragma unroll
        for (int f = 0; f < 16; ++f) Wr[f] = *(const volatile LAS bf16x8*)(nslot + f * 1024 + F.lane * 16);
#pragma unroll
        for (int k2 = 0; k2 < 2; ++k2)
#pragma unroll
            for (int dt = 0; dt < 8; ++dt) S[dt] = __builtin_amdgcn_mfma_f32_16x16x32_bf16(Kr[dt * 2 + k2], Vb[k2], S[dt], 0, 0, 0);
#pragma unroll
        for (int mt = 0; mt < 4; ++mt) vn[mt] = (f32x4){bf_lo(Ur[mt].x), bf_hi(Ur[mt].x), bf_lo(Ur[mt].y), bf_hi(Ur[mt].y)};
#pragma unroll
        for (int ks = 0; ks < 4; ++ks) Sb[ks] = pack8(S[2 * ks], S[2 * ks + 1]);
        const int n1 = n + 1;
        const float alv = n1 < 64 ? ala : (n1 < 128 ? alb : alc);
        const float al = __uint_as_float((unsigned)__builtin_amdgcn_readlane((int)__float_as_uint(alv), n1 & 63));
#pragma unroll
        for (int dt = 0; dt < 8; ++dt) S[dt] = S[dt] * al;
    }
}

constexpr int PO_OT = 40960;
__device__ __forceinline__ void p4_out_unit(Frame& F, const Args& a, int unit, const float (&nw)[16]) {
    const int bh = unit / NCHUNK, n = unit % NCHUNK, b = bh >> 2, h = bh & 3, s = F.wave, l15 = F.lane & 15, q = F.lane >> 4;
    const unsigned char* gW = F.dob + DO_W + (size_t)unit * 16384; const unsigned char* gQG = F.dob + DO_QG + (size_t)unit * 16384; const unsigned char* gIN = F.ws + WS_IN + (size_t)unit * 8192;
#pragma unroll
    for (int i = 0; i < 5; ++i) { const int p = F.wave + 8 * i;
        const unsigned char* src = (i < 2 ? gW + p * 1024 : (i < 4 ? gQG + (p - 16) * 1024 : gIN + (p - 32) * 1024)) + F.lane * 16;
        __builtin_amdgcn_global_load_lds((const unsigned*)src, (LAS unsigned*)(F.lds + p * 1024), 16, 0, 2); }
    bf16x8 Sb[4]; f32x4 vn[4];
    { const unsigned char* sfr = F.ws + WS_SFR + ((size_t)unit * 8 + s) * 4096 + F.lane * 16;
#pragma unroll
      for (int ks = 0; ks < 4; ++ks) Sb[ks] = __builtin_nontemporal_load((const bf16x8*)(sfr + ks * 1024));
      const unsigned char* gu = F.dob + DO_U + (size_t)unit * 16384 + s * 2048 + F.lane * 8;
#pragma unroll
      for (int mt = 0; mt < 4; ++mt) { const u32x2 u = __builtin_nontemporal_load((const u32x2*)(gu + mt * 512)); vn[mt] = (f32x4){bf_lo(u.x), bf_hi(u.x), bf_lo(u.y), bf_hi(u.y)}; } }
    asm volatile("s_waitcnt vmcnt(0)" ::: "memory");
    __syncthreads();
    const LAS unsigned char* fl = F.lds + F.lane * 16;
#pragma unroll
    for (int ks = 0; ks < 4; ++ks)
#pragma unroll
        for (int mt = 0; mt < 4; ++mt) vn[mt] = __builtin_amdgcn_mfma_f32_16x16x32_bf16(*(const LAS bf16x8*)(fl + (mt * 4 + ks) * 1024), Sb[ks], vn[mt], 0, 0, 0);
    bf16x8 Vb[2]; Vb[0] = pack8(vn[0], vn[1]); Vb[1] = pack8(vn[2], vn[3]);
    LAS float* OT = (LAS float*)(F.lds + PO_OT);
#pragma unroll
    for (int mt = 0; mt < 4; ++mt) {
        f32x4 o = (f32x4){0.f, 0.f, 0.f, 0.f};
#pragma unroll
        for (int ks = 0; ks < 4; ++ks) o = __builtin_amdgcn_mfma_f32_16x16x32_bf16(*(const LAS bf16x8*)(fl + 16384 + (mt * 4 + ks) * 1024), Sb[ks], o, 0, 0, 0);
#pragma unroll
        for (int k2 = 0; k2 < 2; ++k2) o = __builtin_amdgcn_mfma_f32_16x16x32_bf16(*(const LAS bf16x8*)(fl + 32768 + (mt * 2 + k2) * 1024), Vb[k2], o, 0, 0, 0);
#pragma unroll
        for (int r = 0; r < 4; ++r) OT[(16 * mt + 4 * q + r) * 132 + 16 * s + l15] = o[r];
    }
    __syncthreads();
    {
        const int row = F.tid >> 3, seg = F.tid & 7, tabs = 64 * n + row;
        const LAS float* orow = OT + row * 132 + 16 * seg;
        float o[16];
#pragma unroll
        for (int i = 0; i < 4; ++i) { const f32x4 v = *(const LAS f32x4*)(orow + 4 * i); o[4 * i] = v[0]; o[4 * i + 1] = v[1]; o[4 * i + 2] = v[2]; o[4 * i + 3] = v[3]; }
        float ss = 0.f;
#pragma unroll
        for (int i = 0; i < 16; ++i) ss += o[i] * o[i];
        ss += __shfl_xor(ss, 1); ss += __shfl_xor(ss, 2); ss += __shfl_xor(ss, 4);
        {
            const float rs = rsqrtf(ss * (1.f / 128.f) + EPS);
            const bf16_t* zp = (const bf16_t*)(F.ws + WS_PZ) + ((size_t)b * SEQ + tabs - TREAL) * 512 + h * 128 + 16 * seg;
            float z[16]; { float t8[8]; unpack8(__builtin_nontemporal_load((const u32x4*)zp), t8);
#pragma unroll
                for (int i = 0; i < 8; ++i) z[i] = t8[i];
                unpack8(__builtin_nontemporal_load((const u32x4*)(zp + 8)), t8);
#pragma unroll
                for (int i = 0; i < 8; ++i) z[8 + i] = t8[i]; }
            float y[16];
#pragma unroll
            for (int i = 0; i < 16; ++i) y[i] = o[i] * rs * nw[i] * silu_f(z[i]);
            bf16_t* yp = (bf16_t*)(F.ws + WS_YCAT) + ((size_t)b * SEQ + tabs - TREAL) * DM + 512 + h * 128 + 16 * seg;
            u32x4 w0, w1; w0.x = cvt_pk_bf16(y[0], y[1]); w0.y = cvt_pk_bf16(y[2], y[3]); w0.z = cvt_pk_bf16(y[4], y[5]); w0.w = cvt_pk_bf16(y[6], y[7]);
            w1.x = cvt_pk_bf16(y[8], y[9]); w1.y = cvt_pk_bf16(y[10], y[11]); w1.z = cvt_pk_bf16(y[12], y[13]); w1.w = cvt_pk_bf16(y[14], y[15]);
            *(u32x4*)yp = w0; *(u32x4*)(yp + 8) = w1;
        }
    }
    __syncthreads();
}

__device__ __forceinline__ void pe_convert(Frame& F, const Args& a, int witem0, int nwaves, int it_begin, int it_end) {
    LAS float* scr = (LAS float*)(F.lds + F.wave * TR_SCR);
    bf16_t* WGU = (bf16_t*)(F.ws + WS_WE); bf16_t* WDN = (bf16_t*)(F.ws + WS_WED);
    for (int it = it_begin + witem0; it < it_end; it += nwaves) {
        const int e = it / 384; int r = it % 384;
        if (r < 256) { const int up = r >> 7; r &= 127; const int k0 = 64 * (r >> 3), n0 = 64 * (r & 7);
            transpose_tile64<true>(a.in[up ? I_WU : I_WG] + (size_t)e * DM * DEXP, DEXP, DM, WGU + (size_t)e * DM * DM, a.in[I_FFNNW], scr, k0, n0, 256 * (n0 >> 7) + 128 * up + (n0 & 127), F.lane); }
        else { r -= 256; const int k0 = 64 * (r >> 4), n0 = 64 * (r & 15);
            transpose_tile64<true>(a.in[I_WD] + (size_t)e * DEXP * DM, DM, DEXP, WDN + (size_t)e * DM * DEXP, nullptr, scr, k0, n0, n0, F.lane); }
    }
}

constexpr int P6_PART = 0, P6_SS = 98304, P6_HIST = 100352, P6_BASE = 100480, P6_TLO = 100608, P6_THI = 100736, P6_POS = 100864, P6_RS = 101376;
constexpr int CW_TOF = 8192, TOF_LD = 132, CW_TCNT = 12544;
__device__ __forceinline__ void p6_router(Frame& F, const Args& a) {
    const bf16_t* h1 = (const bf16_t*)(F.ws + WS_H1B); const bf16x8* WRF = (const bf16x8*)(F.ws + WS_WRF);
    LAS float* part = (LAS float*)(F.lds + P6_PART); LAS float* ssp = (LAS float*)(F.lds + P6_SS);
    LAS int* hist = (LAS int*)(F.lds + P6_HIST); LAS int* basel = (LAS int*)(F.lds + P6_BASE); LAS int* tlo = (LAS int*)(F.lds + P6_TLO); LAS int* thi = (LAS int*)(F.lds + P6_THI);
    LAS int* posl = (LAS int*)(F.lds + P6_POS);
    unsigned* ctl = (unsigned*)(F.ws + WS_CTL);
    unsigned* gcnt = ctl + CW_CNT; unsigned* tof = ctl + CW_TOF; unsigned* tcnt = ctl + CW_TCNT; int* tile_expert = (int*)(F.ws + WS_TILE);
    bf16_t* XS = (bf16_t*)(F.ws + WS_XS);
    const int l15 = F.lane & 15, q = F.lane >> 4;
    for (int wu = F.vcu; wu < MT / 64; wu += F.G) {
        const int m0 = wu * 64;
        if (F.tid < 32) hist[F.tid] = 0;
        u32x4 ab[4][4]; bf16x8 bw[4][6];
#pragma unroll
        for (int tg = 0; tg < 4; ++tg)
#pragma unroll
            for (int ksl = 0; ksl < 4; ++ksl) ab[tg][ksl] = *(const u32x4*)(h1 + (size_t)(m0 + 16 * tg + l15) * DM + 128 * F.wave + 32 * ksl + 8 * q);
#pragma unroll
        for (int ksl = 0; ksl < 4; ++ksl)
#pragma unroll
            for (int i = 0; i < 6; ++i) bw[ksl][i] = WRF[(size_t)((4 * F.wave + ksl) * 6 + i) * 64 + F.lane];
#pragma unroll
        for (int tg = 0; tg < 4; ++tg) {
            f32x4 acc[3]; acc[0] = acc[1] = acc[2] = (f32x4){0.f, 0.f, 0.f, 0.f}; float ssq = 0.f;
#pragma unroll
            for (int ksl = 0; ksl < 4; ++ksl) {
                float af[8]; unpack8(ab[tg][ksl], af);
#pragma unroll
                for (int i = 0; i < 8; ++i) ssq += af[i] * af[i];
                const bf16x8 av = __builtin_bit_cast(bf16x8, ab[tg][ksl]);
#pragma unroll
                for (int nt = 0; nt < 3; ++nt) { acc[nt] = __builtin_amdgcn_mfma_f32_16x16x32_bf16(av, bw[ksl][2 * nt], acc[nt], 0, 0, 0); acc[nt] = __builtin_amdgcn_mfma_f32_16x16x32_bf16(av, bw[ksl][2 * nt + 1], acc[nt], 0, 0, 0); }
            }
            ssq += __shfl_xor(ssq, 16); ssq += __shfl_xor(ssq, 32);
#pragma unroll
            for (int nt = 0; nt < 3; ++nt)
#pragma unroll
                for (int r = 0; r < 4; ++r) part[((F.wave * 64 + 16 * tg) + 4 * q + r) * 48 + 16 * nt + l15] = acc[nt][r];
            if (q == 0) ssp[F.wave * 64 + 16 * tg + l15] = ssq;
        }
        __syncthreads();
        int e0 = 0, e1 = 0, ls0 = 0, ls1 = 0; float w0 = 0.f, w1 = 0.f, rstd = 0.f;
        if (F.tid < 64) {
            const LAS float* pa = part + F.tid * 48; float sq = 0.f;
#pragma unroll
            for (int w8 = 0; w8 < 8; ++w8) sq += ssp[w8 * 64 + F.tid];
            rstd = rsqrtf(sq * (1.f / DM) + EPS);
            float lg[4]; float mx = -3.0e38f; int gs = 0;
#pragma unroll
            for (int c = 0; c < 4; ++c) { float sv = 0.f;
#pragma unroll
                for (int w8 = 0; w8 < 8; ++w8) sv += pa[w8 * 64 * 48 + c];
                lg[c] = sv * rstd + a.in[I_BGRP][c]; if (lg[c] > mx) { mx = lg[c]; gs = c; } }
            float ps = 0.f;
#pragma unroll
            for (int c = 0; c < 4; ++c) ps += __expf(lg[c] - mx);
            const float pg = 1.f / ps;
            float le[8]; float m1 = -3.0e38f; int i1 = 0;
#pragma unroll
            for (int e = 0; e < 8; ++e) { float sv = 0.f;
#pragma unroll
                for (int w8 = 0; w8 < 8; ++w8) sv += pa[w8 * 64 * 48 + 4 + 8 * gs + e];
                le[e] = sv * rstd + a.in[I_BRT][8 * gs + e]; if (le[e] > m1) { m1 = le[e]; i1 = e; } }
            float m2 = -3.0e38f; int i2 = 0;
#pragma unroll
            for (int e = 0; e < 8; ++e) if (e != i1 && le[e] > m2) { m2 = le[e]; i2 = e; }
            const float x2 = __expf(m2 - m1), inv = pg / (1.f + x2);
            w0 = inv; w1 = x2 * inv; e0 = 8 * gs + i1; e1 = 8 * gs + i2;
            ls0 = __hip_atomic_fetch_add(hist + e0, 1, __ATOMIC_RELAXED, __HIP_MEMORY_SCOPE_WORKGROUP);
            ls1 = __hip_atomic_fetch_add(hist + e1, 1, __ATOMIC_RELAXED, __HIP_MEMORY_SCOPE_WORKGROUP);
        }
        __syncthreads();
        if (F.tid < 32) {
            const int e = F.tid, hcnt = hist[e]; int base = 0, t_lo = 0, t_hi = 0;
            if (hcnt) {
                base = (int)__hip_atomic_fetch_add(gcnt + 64 * e, (unsigned)hcnt, RLX_AGENT);
                const int j0 = base >> 8, j1 = (base + hcnt - 1) >> 8;
                if ((base & 255) == 0) { t_lo = (int)__hip_atomic_fetch_add(tcnt, 1u, RLX_AGENT); tile_expert[t_lo] = (j0 << 8) | e; __hip_atomic_store(tof + e * TOF_LD + j0, (unsigned)t_lo + 1u, RLX_AGENT); }
                if (j1 > j0) { t_hi = (int)__hip_atomic_fetch_add(tcnt, 1u, RLX_AGENT); tile_expert[t_hi] = (j1 << 8) | e; __hip_atomic_store(tof + e * TOF_LD + j1, (unsigned)t_hi + 1u, RLX_AGENT); }
                if ((base & 255) != 0) { unsigned v = 0, sp = 0;
                    while ((v = __hip_atomic_load(tof + e * TOF_LD + j0, RLX_AGENT)) == 0u) { __builtin_amdgcn_s_sleep(1); if (++sp > (1u << 22)) break; }
                    t_lo = (int)v - 1; }
            }
            basel[e] = base; tlo[e] = t_lo; thi[e] = t_hi;
        }
        __syncthreads();
        if (F.tid < 64) { const int m = m0 + F.tid;
            const int b0 = basel[e0], s0 = b0 + ls0, b1 = basel[e1], s1 = b1 + ls1;
            const int p0 = 256 * ((s0 >> 8) == (b0 >> 8) ? tlo[e0] : thi[e0]) + (s0 & 255), p1 = 256 * ((s1 >> 8) == (b1 >> 8) ? tlo[e1] : thi[e1]) + (s1 & 255);
            posl[2 * F.tid] = p0; posl[2 * F.tid + 1] = p1;
            ((float*)(F.ws + WS_EW))[2 * m] = w0; ((float*)(F.ws + WS_EW))[2 * m + 1] = w1;
            ((int*)(F.ws + WS_POS))[2 * m] = p0; ((int*)(F.ws + WS_POS))[2 * m + 1] = p1;
            ((float*)(F.ws + WS_RSC))[p0] = rstd; ((float*)(F.ws + WS_RSC))[p1] = rstd;
            ((int*)(F.ws + WS_TOKOF))[p0] = m; ((int*)(F.ws + WS_TOKOF))[p1] = m; }
        __syncthreads();
        __syncthreads();
    }
}

__device__ __forceinline__ void p10_combine(Frame& F, const Args& a, float* outp) {
    const int gw = F.vcu * 8 + F.wave, NGW = F.G * 8;
    const bf16_t* h1 = (const bf16_t*)(F.ws + WS_H1B); const bf16_t* Y = (const bf16_t*)(F.ws + WS_XS);
    f32x4 fw[4];
#pragma unroll
    for (int j = 0; j < 4; ++j) fw[j] = ((const f32x4*)a.in[I_FINNW])[64 * j + F.lane];
    const int* POS = (const int*)(F.ws + WS_POS); const float* EW = (const float*)(F.ws + WS_EW);
    int pa0 = 0, pa1 = 0; float wa0 = 0.f, wa1 = 0.f;
    u32x2 vb[4]; u32x2 ya[4], yb[4]; float wb0 = 0.f, wb1 = 0.f;
    int m = gw;
    if (m < MT) { pa0 = POS[2 * m]; pa1 = POS[2 * m + 1]; wa0 = EW[2 * m]; wa1 = EW[2 * m + 1]; }
#define P10_LOAD_ROWS(mm) do { const u32x2* row_ = (const u32x2*)(h1 + (size_t)(mm) * DM); const u32x2* y0_ = (const u32x2*)(Y + (size_t)pa0 * DM); const u32x2* y1_ = (const u32x2*)(Y + (size_t)pa1 * DM); \
        _Pragma("unroll") for (int j = 0; j < 4; ++j) { vb[j] = __builtin_nontemporal_load(row_ + 64 * j + F.lane); ya[j] = __builtin_nontemporal_load(y0_ + 64 * j + F.lane); yb[j] = __builtin_nontemporal_load(y1_ + 64 * j + F.lane); } wb0 = wa0; wb1 = wa1; } while (0)
    if (m < MT) { P10_LOAD_ROWS(m); const int m1 = m + NGW; if (m1 < MT) { pa0 = POS[2 * m1]; pa1 = POS[2 * m1 + 1]; wa0 = EW[2 * m1]; wa1 = EW[2 * m1 + 1]; } }
    for (; m < MT; m += NGW) {
        f32x4 v[4]; u32x2 a0[4], a1[4]; const float w0 = wb0, w1 = wb1;
#pragma unroll
        for (int j = 0; j < 4; ++j) { v[j] = (f32x4){bf_lo(vb[j].x), bf_hi(vb[j].x), bf_lo(vb[j].y), bf_hi(vb[j].y)}; a0[j] = ya[j]; a1[j] = yb[j]; }
        const int m1 = m + NGW, m2 = m + 2 * NGW;
        if (m1 < MT) { P10_LOAD_ROWS(m1); if (m2 < MT) { pa0 = POS[2 * m2]; pa1 = POS[2 * m2 + 1]; wa0 = EW[2 * m2]; wa1 = EW[2 * m2 + 1]; } }
        float ss = 0.f;
#pragma unroll
        for (int j = 0; j < 4; ++j) {
            v[j][0] += w0 * bf_lo(a0[j].x) + w1 * bf_lo(a1[j].x); v[j][1] += w0 * bf_hi(a0[j].x) + w1 * bf_hi(a1[j].x);
            v[j][2] += w0 * bf_lo(a0[j].y) + w1 * bf_lo(a1[j].y); v[j][3] += w0 * bf_hi(a0[j].y) + w1 * bf_hi(a1[j].y);
            ss += (v[j][0] * v[j][0] + v[j][1] * v[j][1]) + (v[j][2] * v[j][2] + v[j][3] * v[j][3]); }
        ss = wave_sum(ss);
        const float rs = rsqrtf(ss * (1.f / DM) + EPS);
#pragma unroll
        for (int j = 0; j < 4; ++j) __builtin_nontemporal_store(v[j] * rs * fw[j], (f32x4*)(outp + (size_t)m * DM) + 64 * j + F.lane);
    }
#undef P10_LOAD_ROWS
}

__global__ void __launch_bounds__(512, 2) mk_fwd(Args args) {
    extern __shared__ __attribute__((aligned(16))) unsigned char lds[];
    Frame F;
    F.lds = (LAS unsigned char*)lds;
    F.tid = threadIdx.x; F.lane = F.tid & 63; F.wave = __builtin_amdgcn_readfirstlane(F.tid >> 6);
    F.G = gridDim.x; { const int bx = blockIdx.x; F.vcu = (F.G % 8 == 0) ? (bx % 8) * (F.G / 8) + bx / 8 : bx; }
    F.ws = args.ws; F.dob = (unsigned char*)args.out;
    volatile LAS unsigned* MISC = (volatile LAS unsigned*)(F.lds + LDSCTL_OFF);
    if (F.tid < 16) MISC[F.tid] = 0u;
    __syncthreads();
    unsigned* ctl = (unsigned*)(F.ws + WS_CTL);
    XcdBarrier bar; bar.bar = ctl + CW_BAR; bar.x = 0; bar.st = nullptr;
    const int lo = args.ph_lo, hi = args.ph_hi;
    const bool use_bar = (hi - lo) > 1;
    if (use_bar) bar = xcd_barrier_post(ctl + CW_BAR, MISC + 8);
#define IN(k) (lo <= (k) && (k) < hi)
#define SCAN_ROLES() do { if (F.wave == 0) p4_scan_c(F, bh, sl); else if (F.wave == 1) p4_scan_loader<0>(F, bh, sl); else if (F.wave == 2) p4_scan_loader<1>(F, bh, sl); else if (F.wave == 3) p4_scan_loader<2>(F, bh, sl); \
    else if (F.wave == 5) p4_scan_loader<3>(F, bh, sl); else if (F.wave == 6) p4_scan_loader<4>(F, bh, sl); else if (F.wave == 7) p4_scan_loader<5>(F, bh, sl); } while (0)
#define REP(k) for (int rep_ = 0; rep_ < 1 + ((MK_REPEAT_MASK >> (k)) & 1); ++rep_)
#define SEAM(k) do { if (IN(k) && IN((k) + 1)) xcd_barrier(bar); } while (0)

    if (IN(0)) REP(0) { p0_prologue(F, args); }
    SEAM(0);
    if (IN(1)) REP(1) {
        pg8::Gemm g{(const bf16_t*)(F.ws + WS_XB), (const bf16_t*)(F.ws + WS_WIN), DM};
        pg8::DenseOrder S; S.init(MT / 256, 12, DM, F.G, (int)blockIdx.x);
        pg8::EpiProj E{(bf16_t*)(F.ws + WS_PA), (bf16_t*)(F.ws + WS_PQ), (const float*)(F.ws + WS_RSTD1)};
        pg8::gemm_phase<pg8::EpiProj, pg8::DenseOrder>(F.lds, g, S, E);
    }
    SEAM(1);
    if (IN(2)) REP(2) {
        p3_phase(F, args);
#if MK_PROBE_P2 == 1
        p3_phase(F, args);
#endif
        p2_mixer_a(F, args);
#if MK_PROBE_P2 == 2
        p2_mixer_a(F, args);
#endif
    }
    SEAM(2);
    if (IN(3)) REP(3) {
        if (blockIdx.x < 64) {
            if (F.tid < 9) lds_st_u32((unsigned)(size_t)(F.lds + SC_CTL) + 4 * F.tid, 0u);
            __syncthreads();
            const int bh = (int)(blockIdx.x & 7), sl = (int)(blockIdx.x >> 3);
            SCAN_ROLES();
#if MK_PROBE_P3 == 2
            __syncthreads();
            if (F.tid < 9) lds_st_u32((unsigned)(size_t)(F.lds + SC_CTL) + 4 * F.tid, 0u);
            __syncthreads();
            SCAN_ROLES();
#endif
        }
        else {
            const int j = (int)blockIdx.x - 64, nwg = F.G - 64, nz = nwg >= 192 ? 128 : (nwg * 2) / 3, ne = nwg - nz;
            constexpr int NIT = NEXP * 384;
            const int n_early = (int)((long)NIT * 5 / 12);
            if (j < nz) {
                pg8::Gemm g{(const bf16_t*)(F.ws + WS_XB), (const bf16_t*)(F.ws + WS_WIN), DM};
                const int jx = (nz % 8 == 0) ? (j % 8) * (nz / 8) + j / 8 : j;
                pg8::ZOrder S{jx, nz};
                pg8::EpiZ E{(bf16_t*)(F.ws + WS_PZ), (const float*)(F.ws + WS_RSTD1)};
                pg8::gemm_phase<pg8::EpiZ, pg8::ZOrder>(F.lds, g, S, E);
                __syncthreads();
                pe_convert(F, args, j * 8 + F.wave, nz * 8, n_early, NIT);
            } else {
                pe_convert(F, args, (j - nz) * 8 + F.wave, ne * 8, 0, n_early);
            }
        }
    }
    SEAM(3);
    if (IN(4)) REP(4) {
        float nw[16];
#pragma unroll
        for (int i = 0; i < 16; ++i) nw[i] = args.in[I_GDNNW][16 * (F.tid & 7) + i];
        for (int u = F.vcu; u < 8 * (NCHUNK - 1); u += F.G) p4_out_unit(F, args, (u >> 7) * NCHUNK + 1 + (u & 127), nw);
    }
    SEAM(4);
    if (IN(5)) REP(5) {
        pg8::Gemm g{(const bf16_t*)(F.ws + WS_YCAT), (const bf16_t*)(F.ws + WS_WOUT), DM};
        pg8::DenseOrder S; S.init(MT / 256, DM / 256, DM, F.G, (int)blockIdx.x);
        pg8::EpiRes E{(const bf16_t*)(F.ws + WS_XB), (bf16_t*)(F.ws + WS_H1B)};
        pg8::gemm_phase<pg8::EpiRes, pg8::DenseOrder>(F.lds, g, S, E);
    }
    SEAM(5);
    if (IN(6)) { p6_router(F, args); }
    SEAM(6);
    LAS int* tile_l = (LAS int*)(F.lds + LDS_TILE_OFF);
    LAS int* tval_l = (LAS int*)(F.lds + LDS_TVAL_OFF); LAS int* tord_l = (LAS int*)(F.lds + LDS_TORD_OFF);
    if (IN(8) || IN(9)) {
        if (F.tid < 255) { const int nt_ = (int)ld_agent((const unsigned*)(F.ws + WS_CTL) + CW_TCNT); int te = 0, tv = 0;
            if (F.tid < nt_) { const int pk = ld_agent((const int*)(F.ws + WS_TILE) + F.tid); te = pk & 255;
                const int cnt = (int)ld_agent((const unsigned*)(F.ws + WS_CTL) + CW_CNT + 64 * te) - 256 * (pk >> 8); tv = cnt < 0 ? 0 : (cnt > 256 ? 256 : cnt); }
            tile_l[F.tid] = te; tval_l[F.tid] = tv; }
        if (F.tid == 255) tile_l[255] = (int)ld_agent((const unsigned*)(F.ws + WS_CTL) + CW_TCNT);
        __syncthreads();
        { const int nt_ = tile_l[255]; if (F.tid < nt_) { const int me = tile_l[F.tid]; int rank = 0;
              for (int j = 0; j < nt_; ++j) { const int ej = tile_l[j]; rank += (ej < me || (ej == me && j < F.tid)) ? 1 : 0; }
              tord_l[rank] = F.tid; } }
        __syncthreads(); }
    if (IN(8)) REP(8) {
        pg8::Gemm g{(const bf16_t*)(F.ws + WS_H1B), (const bf16_t*)(F.ws + WS_WE), DM};
        pg8::MoeOrder S{tile_l, tord_l, tile_l[255], 4, F.G, F.vcu, 256u * DM * 2u, (unsigned)DM * DM * 2u, (unsigned*)(F.ws + WS_CTL) + CW_HC, (const int*)(F.ws + WS_TOKOF)};
        pg8::EpiGU E{(bf16_t*)(F.ws + WS_HID), (const float*)(F.ws + WS_RSC), tval_l};
        pg8::gemm_phase<pg8::EpiGU, pg8::MoeOrder>(F.lds, g, S, E);
    }
    if (IN(9)) REP(9) {
        pg8::Gemm g{(const bf16_t*)(F.ws + WS_HID), (const bf16_t*)(F.ws + WS_WED), DEXP};
        const int U8 = 4 * tile_l[255];
        pg8::MoeOrderDown S{tile_l, tord_l, U8, F.G, F.vcu, U8 % F.G, 256u * DEXP * 2u, (unsigned)DM * DEXP * 2u, (const unsigned*)(F.ws + WS_CTL) + CW_HC, (unsigned*)(F.ws + WS_CTL) + CW_BAR + XB_TMO};
        pg8::EpiBf16 E{(bf16_t*)(F.ws + WS_XS), DM, tval_l};
        pg8::gemm_phase<pg8::EpiBf16, pg8::MoeOrderDown>(F.lds, g, S, E);
    }
    SEAM(9);
    if (IN(10)) { if ((MK_REPEAT_MASK >> 10) & 1) p10_combine(F, args, (float*)(F.ws + WS_WE)); p10_combine(F, args, (float*)F.dob); }
#undef IN
#undef REP
#undef SEAM
}

extern "C" void kernel_launch(void* const* d_in, const int* in_sizes, int n_in, void* d_out, int out_size, void* d_ws, size_t ws_size, hipStream_t stream) {
    static int grid = 0;
    if (grid == 0) {
        if (n_in != 20 || out_size != MT * DM || ws_size < WS_END) { fprintf(stderr, "kernel_launch: unexpected shapes (n_in %d, out %d, ws %zu)\n", n_in, out_size, ws_size); grid = -1; return; }
        int dev = 0, cus = 0, per_cu = 0;
        if (hipGetDevice(&dev) != hipSuccess || hipDeviceGetAttribute(&cus, hipDeviceAttributeMultiprocessorCount, dev) != hipSuccess) { grid = -1; return; }
        if (hipFuncSetAttribute((const void*)mk_fwd, hipFuncAttributeMaxDynamicSharedMemorySize, LDS_BYTES) != hipSuccess) { grid = -1; return; }
        if (hipOccupancyMaxActiveBlocksPerMultiprocessor(&per_cu, (const void*)mk_fwd, 512, LDS_BYTES) != hipSuccess || per_cu < 1) { fprintf(stderr, "kernel_launch: occupancy query says %d\n", per_cu); }
        (void)hipGetLastError();
        grid = cus;
        if (grid < 64) { grid = -1; return; }
    }
    if (grid < 0) return;
    (void)hipMemsetAsync((char*)d_ws + WS_CTL, 0, CTL_ZERO_BYTES, stream);
    Args a{};
    for (int i = 0; i < 20; ++i) a.in[i] = (const float*)d_in[i];
    a.out = (float*)d_out; a.ws = (unsigned char*)d_ws;
    if (MK_N_LAUNCHES == 1) { a.ph_lo = 0; a.ph_hi = NPHASE; hipLaunchKernelGGL(mk_fwd, dim3(grid), dim3(512), LDS_BYTES, stream, a); }
    else for (int p = 0; p < NPHASE; ++p) { a.ph_lo = p; a.ph_hi = p + 1; hipLaunchKernelGGL(mk_fwd, dim3(grid), dim3(512), LDS_BYTES, stream, a); }
}
```

```cpp
#include <hip/hip_runtime.h>
#include <cstdio>
#include <cstdint>

#ifndef MK_N_LAUNCHES
#define MK_N_LAUNCHES 1
#endif
#ifndef MK_PROBE_P2
#define MK_PROBE_P2 0
#endif
#ifndef MK_PROBE_P3
#define MK_PROBE_P3 0
#endif
#ifndef MK_INIT_IN_KERNEL
#define MK_INIT_IN_KERNEL 1
#endif
#ifndef MK_REPEAT_MASK
#define MK_REPEAT_MASK 0
#endif

#define GAS __attribute__((address_space(1)))
#define LAS __attribute__((address_space(3)))
typedef unsigned short bf16_t;
typedef short bf16x8 __attribute__((ext_vector_type(8)));
typedef float f32x4 __attribute__((ext_vector_type(4)));
typedef unsigned u32x4 __attribute__((ext_vector_type(4)));
typedef unsigned u32x2 __attribute__((ext_vector_type(2)));

constexpr int NB = 2, SEQ = 8192, NMETA = 16, DM = 1024;
constexpr int TPAD = 48, TREAL = TPAD + NMETA;
constexpr int NCHUNK = 129, LP = NCHUNK * 64;
constexpr int MR = NB * LP;
constexpr int MRP = 65 * 256;
constexpr int MT = NB * SEQ;
constexpr int NPROJ = 3584;
constexpr int PROJ_LD = 3592;
constexpr int NEXP = 32, DEXP = 512;
constexpr int ROWS_CAP = 160 * 256;
constexpr int NUNIT_GDN = 8 * NCHUNK;
constexpr float EPS = 1e-6f;
constexpr int NPHASE = 11;

constexpr size_t MiB = 1u << 20;
constexpr size_t WS_CTL = 0, CTL_ZERO_BYTES = 131072;
constexpr size_t WS_WIN = 1 * MiB;
constexpr size_t WS_WOUT = 8 * MiB;
constexpr size_t WS_SMALL = 10 * MiB;
constexpr size_t WS_RSTD1 = WS_SMALL;
constexpr size_t WS_GB = WS_RSTD1 + 128 * 1024;
constexpr size_t WS_WRF = WS_GB + 640 * 1024;
constexpr size_t WS_RSTD2 = WS_WRF + 256 * 1024;
constexpr size_t WS_EIDX = WS_RSTD2 + 64 * 1024;
constexpr size_t WS_EW = WS_EIDX + 128 * 1024;
constexpr size_t WS_SLOT = WS_EW + 128 * 1024;
constexpr size_t WS_POS = WS_SLOT + 128 * 1024;
constexpr size_t WS_RSC = WS_POS + 128 * 1024;
constexpr size_t WS_TILE = WS_RSC + 192 * 1024;
constexpr size_t WS_ALAST = WS_TILE + 4096;
constexpr size_t WS_TOKOF = WS_ALAST + 8192;
static_assert(WS_TOKOF + ROWS_CAP * 4 <= 16 * MiB, "small region");
constexpr size_t WS_XB = 16 * MiB;
constexpr size_t WS_YCAT = 48 * MiB;
constexpr size_t WS_PZ = 80 * MiB;
constexpr size_t WS_KD = 240 * MiB;
constexpr size_t WS_IN = 256 * MiB + 512 * 1024;
constexpr size_t WS_PA = 109 * MiB;
constexpr size_t WS_PQ = 158 * MiB;
constexpr size_t WS_WE = 96 * MiB + 512 * 1024;
constexpr size_t WS_WED = WS_WE + 64 * MiB;
constexpr size_t WS_H8 = WS_WE + 32 * MiB;
constexpr size_t WS_XS = 16 * MiB;
constexpr size_t WS_HID = 192 * MiB + 512 * 1024;
constexpr size_t WS_SFR = 207 * MiB;
constexpr size_t WS_H1B = 232 * MiB + 512 * 1024;
constexpr size_t WS_END = 265 * MiB;
constexpr size_t DO_W = 0, DO_U = 17 * MiB, DO_QG = 34 * MiB;

constexpr int CW_BAR = 0;
constexpr int CW_CNT = 4096;
constexpr int CW_MAGIC = 16128;
constexpr unsigned long long CTL_MAGIC = 0x9E3779B97F4A7C15ull;
constexpr int CW_PC = 21504;
constexpr int CW_HC = 16384, HC_LD = 32;

constexpr int RING_BYTES = 131072;
constexpr int LDS_BYTES = 147456;
constexpr int LDSCTL_OFF = LDS_BYTES - 3328;
constexpr int LDS_TILE_OFF = LDSCTL_OFF + 256;
constexpr int LDS_TORD_OFF = LDS_TILE_OFF + 2048;
constexpr int LDS_TVAL_OFF = LDS_TILE_OFF + 1024;
constexpr int SC_SLOT = 34816, SC_CTL = 4 * SC_SLOT;
static_assert(SC_CTL + 64 <= LDSCTL_OFF, "scan ring vs control words");

#define LDS_WAIT() asm volatile("s_waitcnt lgkmcnt(0)" ::: "memory")
#define VM_WAIT() asm volatile("s_waitcnt vmcnt(0)" ::: "memory")
#define RLX_AGENT __ATOMIC_RELAXED, __HIP_MEMORY_SCOPE_AGENT

typedef __bf16 bf16x2_t __attribute__((ext_vector_type(2)));
typedef float f32x2_t __attribute__((ext_vector_type(2)));
__device__ __forceinline__ unsigned cvt_pk_bf16(float lo, float hi) { const f32x2_t f = {lo, hi}; const bf16x2_t v = __builtin_convertvector(f, bf16x2_t); return __builtin_bit_cast(unsigned, v); }
__device__ __forceinline__ unsigned cvt_pk4_fp8(float a, float b, float c, float d) {
    a = __builtin_amdgcn_fmed3f(a, -448.f, 448.f); b = __builtin_amdgcn_fmed3f(b, -448.f, 448.f); c = __builtin_amdgcn_fmed3f(c, -448.f, 448.f); d = __builtin_amdgcn_fmed3f(d, -448.f, 448.f);
    int w = 0; w = __builtin_amdgcn_cvt_pk_fp8_f32(a, b, w, false); w = __builtin_amdgcn_cvt_pk_fp8_f32(c, d, w, true); return (unsigned)w; }
constexpr float F8_SA = 8.f, F8_SH = 8.f, F8_SWG = 512.f, F8_SWD = 256.f, F8_SY = 32.f;
__device__ __forceinline__ float bf_lo(unsigned u) { return __uint_as_float(u << 16); }
__device__ __forceinline__ float bf_hi(unsigned u) { return __uint_as_float(u & 0xffff0000u); }
template <int CTRL> __device__ __forceinline__ float dpp_all(float v) { const int x = __builtin_bit_cast(int, v); return __builtin_bit_cast(float, __builtin_amdgcn_update_dpp(x, x, CTRL, 0xF, 0xF, true)); }
template <int CTRL, int RMASK> __device__ __forceinline__ float dpp_or0(float v) { return __builtin_bit_cast(float, __builtin_amdgcn_update_dpp(0, __builtin_bit_cast(int, v), CTRL, RMASK, 0xF, false)); }
__device__ __forceinline__ float sum8(float v) { v += dpp_all<0xB1>(v); v += dpp_all<0x4E>(v); v += dpp_all<0x141>(v); return v; }
__device__ __forceinline__ float row_sum16(float v) { v = sum8(v); v += dpp_all<0x140>(v); return v; }
__device__ __forceinline__ float wave_sum(float v) {
    v = row_sum16(v);
    const int x = __builtin_bit_cast(int, v);
    return (__builtin_bit_cast(float, __builtin_amdgcn_readlane(x, 0)) + __builtin_bit_cast(float, __builtin_amdgcn_readlane(x, 16))) + (__builtin_bit_cast(float, __builtin_amdgcn_readlane(x, 32)) + __builtin_bit_cast(float, __builtin_amdgcn_readlane(x, 48)));
}
__device__ __forceinline__ float wave_scan_incl(float v) {
    v += dpp_or0<0x111, 0xF>(v); v += dpp_or0<0x112, 0xF>(v); v += dpp_or0<0x114, 0xF>(v); v += dpp_or0<0x118, 0xF>(v);
    v += dpp_or0<0x142, 0xA>(v);
    v += dpp_or0<0x143, 0xC>(v);
    return v;
}
__device__ __forceinline__ float silu_f(float x) { return x * __builtin_amdgcn_rcpf(1.f + __expf(-x)); }
template <class T> __device__ __forceinline__ T ld_agent(const T* p) { return __hip_atomic_load(p, RLX_AGENT); }

#define XB_TMO      128
#define XB_XCNT(j)  (256  + 64 * (j))
#define XB_XSUB(j)  (1280 + 64 * (j))
#define XB_XGEN(j)  (2304 + 64 * (j))
#define XB_TOP      3328
#define XB_TOPGEN   3392
#define XCD_BAR_WORDS 3456
#define XB_SPIN_CAP (1u << 18)
__device__ __forceinline__ unsigned xb_ld(unsigned* p)              { return __hip_atomic_load(p, __ATOMIC_RELAXED, __HIP_MEMORY_SCOPE_AGENT); }
__device__ __forceinline__ unsigned xb_add(unsigned* p, unsigned v) { return __hip_atomic_fetch_add(p, v, __ATOMIC_RELAXED, __HIP_MEMORY_SCOPE_AGENT); }
__device__ __forceinline__ unsigned xb_xcc_id() { return (unsigned)__builtin_amdgcn_s_getreg((3 << 11) | 20) & 0xFu; }
#define XB_SPIN(cond, bar) do { unsigned _sp = 0; while (cond) { __builtin_amdgcn_s_sleep(1); \
    if ((++_sp & 255u) == 0u) { if (xb_ld(&(bar)[XB_TMO])) break; if (_sp > XB_SPIN_CAP) { atomicAdd(&(bar)[XB_TMO], 1u); break; } } } } while (0)
struct XcdBarrier { unsigned* bar; unsigned x; volatile LAS unsigned* st; };
__device__ __forceinline__ XcdBarrier xcd_barrier_post(unsigned* bar, volatile LAS unsigned* st) {
    XcdBarrier b; b.bar = bar; b.x = xb_xcc_id(); b.st = st;
    if (threadIdx.x == 0) (void)xb_add(&bar[XB_XCNT(b.x)], 1u);
    return b;
}
__device__ __forceinline__ void xcd_barrier_complete(unsigned* bar, unsigned x, unsigned& nloc, unsigned& nx) {
    const unsigned G = gridDim.x * gridDim.y * gridDim.z;
    unsigned sum, cnt, mine, sp = 0u;
    for (;;) {
        sum = 0u; cnt = 0u; mine = 0u;
#pragma unroll
        for (unsigned j = 0; j < 16; ++j) { const unsigned c = xb_ld(&bar[XB_XCNT(j)]); sum += c; cnt += (c > 0u) ? 1u : 0u; mine = (j == x) ? c : mine; }
        if (sum == G) break;
        __builtin_amdgcn_s_sleep(1);
        if ((++sp & 255u) == 0u) { if (xb_ld(&bar[XB_TMO])) break; if (sp > XB_SPIN_CAP) { atomicAdd(&bar[XB_TMO], 1u); break; } }
    }
    nloc = mine > 0u ? mine : 1u; nx = cnt > 0u ? cnt : 1u;
}
__device__ __forceinline__ void xcd_barrier(const XcdBarrier& b) {
    asm volatile("s_waitcnt vmcnt(0)" ::: "memory");
    __syncthreads();
    if (threadIdx.x == 0) {
        unsigned* bar = b.bar;
        __builtin_amdgcn_s_waitcnt(0);
        unsigned nloc = b.st[0], nx = b.st[1];
        if (nloc == 0u) { xcd_barrier_complete(bar, b.x, nloc, nx); b.st[0] = nloc; b.st[1] = nx; }
        const unsigned old = xb_add(&bar[XB_XSUB(b.x)], 1u);
        const unsigned gen = old / nloc;
        if (old + 1u == (gen + 1u) * nloc) {
            __builtin_amdgcn_fence(__ATOMIC_RELEASE, "agent");
            asm volatile("s_waitcnt vmcnt(0)" ::: "memory");
            __builtin_amdgcn_fence(__ATOMIC_ACQUIRE, "agent");
            const unsigned og = xb_add(&bar[XB_TOP], 1u);
            const unsigned tg = og / nx;
            if (og + 1u == (tg + 1u) * nx) xb_add(&bar[XB_TOPGEN], 1u);
            else XB_SPIN(xb_ld(&bar[XB_TOPGEN]) == tg, bar);
            asm volatile("s_waitcnt vmcnt(0)" ::: "memory");
            xb_add(&bar[XB_XGEN(b.x)], 1u);
            asm volatile("s_waitcnt vmcnt(0)" ::: "memory");
        } else {
            __builtin_amdgcn_fence(__ATOMIC_ACQUIRE, "agent");
            asm volatile("s_waitcnt vmcnt(0)" ::: "memory");
            XB_SPIN(xb_ld(&bar[XB_XGEN(b.x)]) == gen, bar);
        }
    }
    __syncthreads();
}

namespace pg8 {
constexpr int BM = 256, BK = 64, HALF = 128, HTB = HALF * BK * 2, NXCD = 8, WGM = 8;
__host__ __device__ __forceinline__ int lds_byte(int r, int c) { const int st = (r >> 4) * 2 + (c >> 5), rr = r & 15, cc = c & 31, ob = rr * 64 + cc * 2; return st * 1024 + (ob ^ (((ob >> 9) & 1) << 5)); }
__host__ __device__ __forceinline__ void stage_rc(int b, int& R, int& C) { const int st = b / 1024, sb = b % 1024, swz = sb ^ (((sb >> 9) & 1) << 5); R = (st >> 1) * 16 + swz / 64; C = (st & 1) * 32 + (swz % 64) / 2; }
__host__ __device__ __forceinline__ int perm32(int rho) { const int n = rho >> 4, i = rho & 15; return 8 * (i >> 2) + 4 * n + (i & 3); }

struct Unit { unsigned aoff, boff; int pm, pn, hf; };
struct Gemm { const bf16_t* A; const bf16_t* Bt; int K; };

struct DenseOrder {
    static constexpr bool GATHER = false, HALF = false;
    int nM, nN, nwg, G, c; unsigned pstep;
    __device__ void init(int nM_, int nN_, int K, int G_, int c_) { nM = nM_; nN = nN_; nwg = nM * nN; G = G_; c = c_; pstep = 256u * (unsigned)K * 2u; }
    __device__ bool next(int i, Unit& u) const {
        const long L = (long)i * G + c; if (L >= nwg) return false;
        int wgid = (int)L; { const int q = nwg / NXCD, r = nwg % NXCD, xcd = wgid % NXCD, off = wgid / NXCD; wgid = (xcd < r ? xcd * (q + 1) : r * (q + 1) + (xcd - r) * q) + off; }
        const int nig = WGM * nN, gid = wgid / nig, fm = gid * WGM, gsz = (nM - fm) < WGM ? (nM - fm) : WGM;
        u.pm = fm + ((wgid % nig) % gsz); u.pn = (wgid % nig) / gsz; u.aoff = (unsigned)u.pm * pstep; u.boff = (unsigned)u.pn * pstep; return true;
    }
    __device__ __forceinline__ void a_ready(const Unit&) const {}
    __device__ __forceinline__ void done(const Unit&) const {}
};
struct DenseOrderPub : DenseOrder {
    unsigned* pc;
    __device__ __forceinline__ void done(const Unit& u) const {
        asm volatile("s_waitcnt vmcnt(0)" ::: "memory");
        if ((threadIdx.x & 63) == 0) __hip_atomic_fetch_add(pc + u.pm * HC_LD, 1u, __ATOMIC_RELAXED, __HIP_MEMORY_SCOPE_AGENT);
    }
};
struct MoeOrder {
    static constexpr bool HALF = true;
    static constexpr bool GATHER = true;
    const LAS int* tile_e; const LAS int* tord; int ntiles, nN, G, c; unsigned pstep, estep;
    __device__ bool next(int i, Unit& u) const {
        const long L = (long)i * G + c; if (L >= (long)ntiles * nN) return false;
        const int rt = tord[(int)L / nN], pn = (int)L % nN; const int e = tile_e[rt];
        u.pm = rt; u.pn = pn; u.hf = tval[rt] <= 128; u.aoff = (unsigned)rt * pstep; u.boff = (unsigned)e * estep + (unsigned)pn * pstep; return true;
    }
    __device__ __forceinline__ void a_ready(const Unit&) const {}
    unsigned* hc; const int* tok; const LAS int* tval;
    __device__ __forceinline__ void done(const Unit& u) const {
        asm volatile("s_waitcnt vmcnt(0)" ::: "memory");
        if ((threadIdx.x & 63) == 0) __hip_atomic_fetch_add(hc + u.pm * HC_LD, 1u, __ATOMIC_RELAXED, __HIP_MEMORY_SCOPE_AGENT);
    }
};
struct MoeOrderDown {
    static constexpr bool GATHER = false, HALF = true;
    const LAS int* tile_e; const LAS int* tord; int U, G, c, r; unsigned pstep, estep; const unsigned* hc; unsigned* tmo; const LAS int* tval;
    __device__ bool next(int i, Unit& u) const {
        long L;
        if (c < r) L = 2L * (G - r) + (long)i * G + c;
        else L = i < 2 ? (long)i * (G - r) + (c - r) : 2L * (G - r) + (long)(i - 2) * G + c;
        if (L >= U) return false;
        const int rt = tord[(int)L >> 2], pn = (int)L & 3; const int e = tile_e[rt];
        u.pm = rt; u.pn = pn; u.hf = tval[rt] <= 128; u.aoff = (unsigned)rt * pstep; u.boff = (unsigned)e * estep + (unsigned)pn * pstep; return true;
    }
    __device__ __forceinline__ void a_ready(const Unit& u) const {
        if (threadIdx.x < 64) { unsigned sp = 0;
            while ((unsigned)__builtin_amdgcn_readfirstlane((int)__hip_atomic_load(hc + u.pm * HC_LD, __ATOMIC_RELAXED, __HIP_MEMORY_SCOPE_AGENT)) < 32u) {
                __builtin_amdgcn_s_sleep(8); if (++sp > (1u << 20)) { if (threadIdx.x == 0) __hip_atomic_store(tmo, 1u, __ATOMIC_RELAXED, __HIP_MEMORY_SCOPE_AGENT); break; } }
            __builtin_amdgcn_fence(__ATOMIC_ACQUIRE, "agent");
            asm volatile("s_waitcnt vmcnt(0)" ::: "memory"); }
        asm volatile("" ::: "memory"); __builtin_amdgcn_s_barrier(); asm volatile("" ::: "memory");
    }
    __device__ __forceinline__ void done(const Unit&) const {}
};

typedef int i32x8 __attribute__((ext_vector_type(8)));
typedef int i32x4v __attribute__((ext_vector_type(4)));
__device__ __forceinline__ i32x8 pg8_cat(const bf16x8 a, const bf16x8 b) {
    const i32x4v x = __builtin_bit_cast(i32x4v, a), y = __builtin_bit_cast(i32x4v, b);
    return __builtin_shufflevector(x, y, 0, 1, 2, 3, 4, 5, 6, 7); }
template <class Epi, class Sched>
__device__ __forceinline__ void gemm_phase(LAS unsigned char* lds, const Gemm g, const Sched& S, const Epi& E) {
    const int tid = threadIdx.x, wid = __builtin_amdgcn_readfirstlane(tid >> 6), lane = tid & 63, wr = wid >> 2, wc = wid & 3, fr = lane & 15, fq = lane >> 4;
    const int K = g.K, nt = K / BK;
    unsigned voffA[2], voffB[2];
#pragma unroll
    for (int i = 0; i < 2; ++i) { int R, C; stage_rc(tid * 16 + i * 8192, R, C); const int Rb = Epi::PERM ? ((R & ~31) + perm32(R & 31)) : R;
        voffA[i] = (unsigned)(R * K + C) * 2u; voffB[i] = (unsigned)(Rb * K + C) * 2u; }
    const unsigned kstep = (unsigned)(BK * 2);
    const unsigned hstep = (unsigned)HALF * (unsigned)K * 2u;
    const __amdgpu_buffer_rsrc_t rsA = __builtin_amdgcn_make_buffer_rsrc((void*)g.A, 0, 0x7fffffff, 0x00020000), rsB = __builtin_amdgcn_make_buffer_rsrc((void*)g.Bt, 0, 0x7fffffff, 0x00020000);
    const unsigned ldsw = (unsigned)wid * 1024u;
    unsigned cG[2][2], nG[2][2]; int gR[2], gC[2];
    if constexpr (Sched::GATHER) {
#pragma unroll
        for (int i = 0; i < 2; ++i) { int R, C; stage_rc(tid * 16 + i * 8192, R, C); gR[i] = R; gC[i] = C * 2; } }
#define PG8_GIDX(dst, un) do { _Pragma("unroll") for (int _h = 0; _h < 2; ++_h) _Pragma("unroll") for (int _i = 0; _i < 2; ++_i) dst[_h][_i] = (unsigned)S.tok[(un).pm * 256 + 128 * _h + gR[_i]]; } while (0)
#define PG8_GOFF(dst) do { _Pragma("unroll") for (int _h = 0; _h < 2; ++_h) _Pragma("unroll") for (int _i = 0; _i < 2; ++_i) { unsigned _t = dst[_h][_i]; _t = _t < (unsigned)(MT - 1) ? _t : (unsigned)(MT - 1); \
        dst[_h][_i] = _t * (unsigned)(K * 2) + (unsigned)gC[_i]; } } while (0)
#define PG8_STAGE_G(bufoff, koff, v0, v1) do { \
        __builtin_amdgcn_raw_ptr_buffer_load_lds(rsA, (LAS unsigned*)(lds + (bufoff) + ldsw), 16, (int)(v0), (int)(koff), 0, 0); \
        __builtin_amdgcn_raw_ptr_buffer_load_lds(rsA, (LAS unsigned*)(lds + (bufoff) + ldsw + 8192), 16, (int)(v1), (int)(koff), 0, 0); } while (0)
    const int aoff = lds_byte(wr * 64 + fr, fq * 8), boff = lds_byte(wc * 32 + fr, fq * 8);
#define PG8_SA(b, h) (((b) * 2 + (h)) * HTB)
#define PG8_SB(b, h) ((4 + (b) * 2 + (h)) * HTB)
#define PG8_STAGE_A(bufoff, soff) do { _Pragma("unroll") for (int _i = 0; _i < 2; ++_i) \
        __builtin_amdgcn_raw_ptr_buffer_load_lds(rsA, (LAS unsigned*)(lds + (bufoff) + ldsw + _i * 8192), 16, (int)voffA[_i], (int)(soff), 0, 0); } while (0)
#define PG8_STAGE_B(bufoff, soff) do { _Pragma("unroll") for (int _i = 0; _i < 2; ++_i) \
        __builtin_amdgcn_raw_ptr_buffer_load_lds(rsB, (LAS unsigned*)(lds + (bufoff) + ldsw + _i * 8192), 16, (int)voffB[_i], (int)(soff), 0, 0); } while (0)
#define PG8_LDA(dst, b, h) do { _Pragma("unroll") for (int m = 0; m < 4; ++m) _Pragma("unroll") for (int k = 0; k < 2; ++k) dst[m][k] = *(const LAS bf16x8*)(lds + PG8_SA(b, h) + aoff + m * 2048 + k * 1024); } while (0)
#define PG8_LDB(dst, b, h) do { _Pragma("unroll") for (int n = 0; n < 2; ++n) _Pragma("unroll") for (int k = 0; k < 2; ++k) dst[n][k] = *(const LAS bf16x8*)(lds + PG8_SB(b, h) + boff + n * 2048 + k * 1024); } while (0)
#define PG8_MMA(ai, bj, At, Bt) do { __builtin_amdgcn_s_setprio(1); \
        if constexpr (Epi::FP8) { _Pragma("unroll") for (int m = 0; m < 4; ++m) _Pragma("unroll") for (int n = 0; n < 2; ++n) \
            acc[ai][bj][m][n] = __builtin_amdgcn_mfma_scale_f32_16x16x128_f8f6f4(pg8_cat(Bt[n][0], Bt[n][1]), pg8_cat(At[m][0], At[m][1]), acc[ai][bj][m][n], 0, 0, 0, 0, 0, 0); } \
        else { _Pragma("unroll") for (int m = 0; m < 4; ++m) _Pragma("unroll") for (int n = 0; n < 2; ++n) _Pragma("unroll") for (int k = 0; k < 2; ++k) \
            acc[ai][bj][m][n] = __builtin_amdgcn_mfma_f32_16x16x32_bf16(Bt[n][k], At[m][k], acc[ai][bj][m][n], 0, 0, 0); } \
        __builtin_amdgcn_s_setprio(0); } while (0)
#define PG8_WAIT_V(n) asm volatile("s_waitcnt vmcnt(" #n ")" ::: "memory")
#define PG8_WAIT_L(n) asm volatile("s_waitcnt lgkmcnt(" #n ")" ::: "memory")
#define PG8_BAR __builtin_amdgcn_s_barrier()
#define PG8_SCHED __builtin_amdgcn_sched_barrier(0)
    Unit cur, nxt; int ui = 0;
    if (!S.next(0, cur)) return;
    f32x4 acc[2][2][4][2];
#pragma unroll
    for (int a = 0; a < 2; ++a)
#pragma unroll
        for (int b = 0; b < 2; ++b)
#pragma unroll
            for (int m = 0; m < 4; ++m)
#pragma unroll
                for (int n = 0; n < 2; ++n) acc[a][b][m][n] = (f32x4){0.f, 0.f, 0.f, 0.f};
    bf16x8 At[4][2], B0[2][2], B1[2][2];
    unsigned cA = cur.aoff, cB = cur.boff;
    bool hf = false; if constexpr (Sched::HALF) hf = __builtin_amdgcn_readfirstlane(cur.hf) != 0;
    S.a_ready(cur);
    if constexpr (Sched::GATHER) { PG8_GIDX(cG, cur); Unit n1; if (S.next(1, n1)) PG8_GIDX(nG, n1); else PG8_GIDX(nG, cur); PG8_GOFF(cG); PG8_GOFF(nG); }
    PG8_STAGE_B(PG8_SB(0, 0), cB); PG8_STAGE_B(PG8_SB(0, 1), cB + hstep);
    if constexpr (Sched::GATHER) { PG8_STAGE_G(PG8_SA(0, 0), 0, cG[0][0], cG[0][1]); PG8_STAGE_G(PG8_SA(0, 1), 0, cG[1][0], cG[1][1]); }
    else { PG8_STAGE_A(PG8_SA(0, 0), cA); PG8_STAGE_A(PG8_SA(0, 1), cA + hstep); }
    if (wr == 1) PG8_BAR;
    PG8_WAIT_V(2); PG8_BAR;
    PG8_STAGE_B(PG8_SB(1, 0), cB + kstep);
    if constexpr (Sched::GATHER) PG8_STAGE_G(PG8_SA(1, 0), kstep, cG[0][0], cG[0][1]); else PG8_STAGE_A(PG8_SA(1, 0), cA + kstep);
    PG8_STAGE_B(PG8_SB(1, 1), cB + hstep + kstep);
    PG8_WAIT_V(6); PG8_BAR;
    for (;;) {
        const bool has_next = S.next(ui + 1, nxt);
        const unsigned nA = has_next ? nxt.aoff : cA, nB = has_next ? nxt.boff : cB;
        for (int t = 0; t < nt; t += 2) {
            const bool last = (t == nt - 2);
            const unsigned a1 = cA + (unsigned)(t + 1) * kstep;
            const unsigned a2 = last ? nA : cA + (unsigned)(t + 2) * kstep, b2 = last ? nB : cB + (unsigned)(t + 2) * kstep;
            const unsigned a3 = a2 + kstep, b3 = b2 + kstep;
            if (last && has_next) S.a_ready(nxt);
            const unsigned ko1 = (unsigned)(t + 1) * kstep, ko2 = last ? 0u : (unsigned)(t + 2) * kstep, ko3 = ko2 + kstep; const bool un = last && has_next;
            PG8_LDB(B0, 0, 0); PG8_LDB(B1, 0, 1); PG8_SCHED; PG8_LDA(At, 0, 0);
            if constexpr (Sched::GATHER) PG8_STAGE_G(PG8_SA(1, 1), ko1, cG[1][0], cG[1][1]); else PG8_STAGE_A(PG8_SA(1, 1), a1 + hstep);
            PG8_WAIT_V(8); PG8_WAIT_L(0); PG8_BAR; PG8_MMA(0, 0, At, B0); PG8_MMA(0, 1, At, B1); PG8_BAR; PG8_SCHED;
            if (!hf) PG8_LDA(At, 0, 1);
            PG8_STAGE_B(PG8_SB(0, 0), b2); PG8_STAGE_B(PG8_SB(0, 1), b2 + hstep);
            if constexpr (Sched::GATHER) PG8_STAGE_G(PG8_SA(0, 0), ko2, un ? nG[0][0] : cG[0][0], un ? nG[0][1] : cG[0][1]); else PG8_STAGE_A(PG8_SA(0, 0), a2);
            PG8_WAIT_V(8); PG8_WAIT_L(0); PG8_BAR; if (!hf) { PG8_MMA(1, 0, At, B0); PG8_MMA(1, 1, At, B1); } PG8_BAR; PG8_SCHED;
            PG8_LDB(B0, 1, 0); PG8_LDB(B1, 1, 1); PG8_SCHED; PG8_LDA(At, 1, 0);
            if constexpr (Sched::GATHER) PG8_STAGE_G(PG8_SA(0, 1), ko2, un ? nG[1][0] : cG[1][0], un ? nG[1][1] : cG[1][1]); else PG8_STAGE_A(PG8_SA(0, 1), a2 + hstep);
            PG8_WAIT_V(8); PG8_WAIT_L(0); PG8_BAR; PG8_MMA(0, 0, At, B0); PG8_MMA(0, 1, At, B1); PG8_BAR; PG8_SCHED;
            if (!hf) PG8_LDA(At, 1, 1);
            PG8_STAGE_B(PG8_SB(1, 0), b3); PG8_STAGE_B(PG8_SB(1, 1), b3 + hstep);
            if constexpr (Sched::GATHER) PG8_STAGE_G(PG8_SA(1, 0), ko3, un ? nG[0][0] : cG[0][0], un ? nG[0][1] : cG[0][1]); else PG8_STAGE_A(PG8_SA(1, 0), a3);
            PG8_WAIT_V(8); PG8_WAIT_L(0); PG8_BAR;
            if constexpr (Epi::SPLIT) { if (last) E.half(acc, cur, wr, wc, fr, fq, 0); }
            if (!hf) { PG8_MMA(1, 0, At, B0); PG8_MMA(1, 1, At, B1); } PG8_BAR; PG8_SCHED;
        }
        if (wr == 0) PG8_BAR;
        unsigned xG[2][2];
        if constexpr (Sched::GATHER) { Unit n2; if (S.next(ui + 2, n2)) PG8_GIDX(xG, n2); else PG8_GIDX(xG, cur); }
        if constexpr (Epi::SPLIT) E.half(acc, cur, wr, wc, fr, fq, 1); else E(acc, cur, wr, wc, fr, fq);
        S.done(cur);
        if constexpr (Sched::GATHER) { PG8_GOFF(xG);
#pragma unroll
            for (int h_ = 0; h_ < 2; ++h_)
#pragma unroll
                for (int i_ = 0; i_ < 2; ++i_) { cG[h_][i_] = nG[h_][i_]; nG[h_][i_] = xG[h_][i_]; } }
        if (!has_next) break;
#pragma unroll
        for (int a = 0; a < 2; ++a)
#pragma unroll
            for (int b = 0; b < 2; ++b)
#pragma unroll
                for (int m = 0; m < 4; ++m)
#pragma unroll
                    for (int n = 0; n < 2; ++n) acc[a][b][m][n] = (f32x4){0.f, 0.f, 0.f, 0.f};
        cur = nxt; cA = nA; cB = nB; ++ui;
        if constexpr (Sched::HALF) hf = __builtin_amdgcn_readfirstlane(cur.hf) != 0;
        if (wr == 1) PG8_BAR;
    }
    PG8_WAIT_V(0);
    PG8_BAR;
#undef PG8_SA
#undef PG8_SB
#undef PG8_STAGE_A
#undef PG8_STAGE_B
#undef PG8_GIDX
#undef PG8_GOFF
#undef PG8_STAGE_G
#undef PG8_LDA
#undef PG8_LDB
#undef PG8_MMA
#undef PG8_WAIT_V
#undef PG8_WAIT_L
#undef PG8_BAR
#undef PG8_SCHED
}

struct EpiProj {
    static constexpr bool PERM = true, FP8 = false, SPLIT = true;
    bf16_t *pa, *pq; const float* rstd;
    __device__ __forceinline__ void operator()(const f32x4 (&acc)[2][2][4][2], const Unit& u, int wr, int wc, int fr, int fq) const { half(acc, u, wr, wc, fr, fq, 0); half(acc, u, wr, wc, fr, fq, 1); }
    __device__ __forceinline__ void half(const f32x4 (&acc)[2][2][4][2], const Unit& u, int wr, int wc, int fr, int fq, const int ai) const {
        const int row0 = u.pm * BM + wr * 64 + fr; int colt = u.pn * BM; bf16_t* base = pa;
        if (colt >= 1536) { base = pq; colt -= 1536; }
        const int col0 = colt + wc * 32 + 8 * fq;
        const __amdgpu_buffer_rsrc_t rs = __builtin_amdgcn_make_buffer_rsrc((void*)base, 0, MR * 1536 * 2, 0x00020000);
#pragma unroll
            for (int m = 0; m < 4; ++m) { const int row = row0 + ai * HALF + m * 16;
                const int orow = row + TREAL + (row >= SEQ ? (LP - SEQ) : 0);
                const int bo = (orow * 1536 + col0) * 2;
#pragma unroll
                for (int bj = 0; bj < 2; ++bj) { const f32x4 v0 = acc[ai][bj][m][0], v1 = acc[ai][bj][m][1];
                    u32x4 w; w.x = cvt_pk_bf16(v0[0], v0[1]); w.y = cvt_pk_bf16(v0[2], v0[3]); w.z = cvt_pk_bf16(v1[0], v1[1]); w.w = cvt_pk_bf16(v1[2], v1[3]);
                    __builtin_amdgcn_raw_buffer_store_b128(w, rs, bo + bj * HALF * 2, 0, 0); } }
    }
};
struct EpiZ {
    static constexpr bool PERM = true, FP8 = false, SPLIT = false;
    bf16_t* pz; const float* rstd;
    __device__ __forceinline__ void operator()(const f32x4 (&acc)[2][2][4][2], const Unit& u, int wr, int wc, int fr, int fq) const {
        const int row0 = u.pm * BM + wr * 64 + fr, col0 = u.pn * BM + wc * 32 + 8 * fq;
#pragma unroll
        for (int ai = 0; ai < 2; ++ai)
#pragma unroll
            for (int m = 0; m < 4; ++m) { const int row = row0 + ai * HALF + m * 16;
                bf16_t* rowp = pz + (size_t)row * 512 + col0;
#pragma unroll
                for (int bj = 0; bj < 2; ++bj) { const f32x4 v0 = acc[ai][bj][m][0], v1 = acc[ai][bj][m][1];
                    u32x4 w; w.x = cvt_pk_bf16(v0[0], v0[1]); w.y = cvt_pk_bf16(v0[2], v0[3]); w.z = cvt_pk_bf16(v1[0], v1[1]); w.w = cvt_pk_bf16(v1[2], v1[3]);
                    *(u32x4*)(rowp + bj * HALF) = w; } }
    }
};
struct ZOrder {
    static constexpr bool GATHER = false, HALF = false;
    int j, nw;
    __device__ bool next(int i, Unit& o) const { const int L = j + i * nw; if (L >= 128) return false;
        o.pm = L >> 1; o.pn = L & 1; o.aoff = (unsigned)(L >> 1) * (256u * DM * 2u); o.boff = (unsigned)(12 + (L & 1)) * (256u * DM * 2u); return true; }
    __device__ __forceinline__ void a_ready(const Unit&) const {}
    __device__ __forceinline__ void done(const Unit&) const {}
};
struct EpiRes {
    static constexpr bool PERM = true, FP8 = false, SPLIT = false;
    const bf16_t* xb; bf16_t* h1; unsigned char* h8; const float* rinv;
    __device__ __forceinline__ void operator()(const f32x4 (&acc)[2][2][4][2], const Unit& u, int wr, int wc, int fr, int fq) const {
        const int row0 = u.pm * BM + wr * 64 + fr, col0 = u.pn * BM + wc * 32 + 8 * fq;
        const __amdgpu_buffer_rsrc_t rs = __builtin_amdgcn_make_buffer_rsrc((void*)h1, 0, MT * DM * 2, 0x00020000);
        u32x4 xr[2][4][2]; float ri[2][4];
#pragma unroll
        for (int ai = 0; ai < 2; ++ai)
#pragma unroll
            for (int m = 0; m < 4; ++m) ri[ai][m] = rinv[row0 + ai * HALF + m * 16];
#pragma unroll
        for (int ai = 0; ai < 2; ++ai)
#pragma unroll
            for (int m = 0; m < 4; ++m)
#pragma unroll
                for (int bj = 0; bj < 2; ++bj) xr[ai][m][bj] = __builtin_nontemporal_load((const u32x4*)(xb + (size_t)(row0 + ai * HALF + m * 16) * DM + col0 + bj * HALF));
        const __amdgpu_buffer_rsrc_t rs8 = __builtin_amdgcn_make_buffer_rsrc((void*)h8, 0, MT * DM, 0x00020000);
        const int odd = fq & 1;
#pragma unroll
        for (int ai = 0; ai < 2; ++ai)
#pragma unroll
            for (int mp = 0; mp < 2; ++mp)
#pragma unroll
                for (int bj = 0; bj < 2; ++bj) { u32x2 wp[2];
#pragma unroll
                    for (int t = 0; t < 2; ++t) { const int m = 2 * mp + t; const size_t off = (size_t)(row0 + ai * HALF + m * 16) * DM + col0; const u32x4 x4 = xr[ai][m][bj];
                        const f32x4 v0 = (f32x4){bf_lo(x4.x), bf_hi(x4.x), bf_lo(x4.y), bf_hi(x4.y)} * ri[ai][m] + acc[ai][bj][m][0], v1 = (f32x4){bf_lo(x4.z), bf_hi(x4.z), bf_lo(x4.w), bf_hi(x4.w)} * ri[ai][m] + acc[ai][bj][m][1];
                        u32x4 w; w.x = cvt_pk_bf16(v0[0], v0[1]); w.y = cvt_pk_bf16(v0[2], v0[3]); w.z = cvt_pk_bf16(v1[0], v1[1]); w.w = cvt_pk_bf16(v1[2], v1[3]);
                        __builtin_amdgcn_raw_buffer_store_b128(w, rs, (int)(off + bj * HALF) * 2, 0, 16);
                        wp[t].x = cvt_pk4_fp8(v0[0] * F8_SA, v0[1] * F8_SA, v0[2] * F8_SA, v0[3] * F8_SA); wp[t].y = cvt_pk4_fp8(v1[0] * F8_SA, v1[1] * F8_SA, v1[2] * F8_SA, v1[3] * F8_SA); }
                    const u32x2 s0 = __builtin_amdgcn_permlane16_swap(wp[0].x, wp[1].x, false, false), s1 = __builtin_amdgcn_permlane16_swap(wp[0].y, wp[1].y, false, false);
                    const int off8 = (row0 + ai * HALF + (2 * mp + odd) * 16) * DM + (col0 - 8 * odd) + bj * HALF;
                    __builtin_amdgcn_raw_buffer_store_b128((u32x4){s0.x, s1.x, s0.y, s1.y}, rs8, off8, 0, 0); }
    }
};
struct EpiGU {
    static constexpr bool PERM = true, FP8 = true, SPLIT = false;
    unsigned char* hid; const float* rsc; const LAS int* tvalid;
    __device__ __forceinline__ void operator()(const f32x4 (&acc)[2][2][4][2], const Unit& u, int wr, int wc, int fr, int fq) const {
        const __amdgpu_buffer_rsrc_t rs = __builtin_amdgcn_make_buffer_rsrc((void*)hid, 0, ROWS_CAP * DEXP, 0x00020000);
        const int row0 = u.pm * BM + wr * 64 + fr, colb = u.pn * HALF + wc * 32 + 8 * (fq & ~1), nvalid = tvalid[u.pm] + u.pm * BM, odd = fq & 1;
#pragma unroll
        for (int ai = 0; ai < 2; ++ai)
#pragma unroll
            for (int mp = 0; mp < 2; ++mp) {
                if (u.pm * BM + wr * 64 + ai * HALF + mp * 32 >= nvalid) continue;
                u32x2 wp[2];
#pragma unroll
                for (int t = 0; t < 2; ++t) { const int m = 2 * mp + t; const int row = row0 + ai * HALF + m * 16; const float sc = rsc[row] * (1.f / (F8_SA * F8_SWG));
                    float h[8];
#pragma unroll
                    for (int n = 0; n < 2; ++n)
#pragma unroll
                        for (int i = 0; i < 4; ++i) { const float gt = acc[ai][0][m][n][i] * sc, up = acc[ai][1][m][n][i] * (sc * F8_SH); h[4 * n + i] = silu_f(gt) * up; }
                    wp[t].x = cvt_pk4_fp8(h[0], h[1], h[2], h[3]); wp[t].y = cvt_pk4_fp8(h[4], h[5], h[6], h[7]); }
                const u32x2 s0 = __builtin_amdgcn_permlane16_swap(wp[0].x, wp[1].x, false, false), s1 = __builtin_amdgcn_permlane16_swap(wp[0].y, wp[1].y, false, false);
                const u32x4 w = (u32x4){s0.x, s1.x, s0.y, s1.y};
                const int myrow = row0 + ai * HALF + (2 * mp + odd) * 16;
                if (myrow < nvalid) __builtin_amdgcn_raw_buffer_store_b128(w, rs, myrow * DEXP + colb, 0, 16); }
    }
};
struct EpiBf16 {
    static constexpr bool PERM = true, FP8 = true, SPLIT = false;
    unsigned char* O; int ldc; const LAS int* tvalid;
    __device__ __forceinline__ void operator()(const f32x4 (&acc)[2][2][4][2], const Unit& u, int wr, int wc, int fr, int fq) const {
        const int row0 = u.pm * BM + wr * 64 + fr, colb = u.pn * BM + wc * 32 + 8 * (fq & ~1), nvalid = tvalid[u.pm] + u.pm * BM, odd = fq & 1;
        const __amdgpu_buffer_rsrc_t rsO = __builtin_amdgcn_make_buffer_rsrc((void*)O, 0, ROWS_CAP * DM, 0x00020000);
#pragma unroll
        for (int ai = 0; ai < 2; ++ai)
#pragma unroll
            for (int mp = 0; mp < 2; ++mp) {
                if (u.pm * BM + wr * 64 + ai * HALF + mp * 32 >= nvalid) continue;
                const int myrow = row0 + ai * HALF + (2 * mp + odd) * 16;
                const int bo = myrow * ldc + colb;
#pragma unroll
                for (int bj = 0; bj < 2; ++bj) { u32x2 wp[2];
#pragma unroll
                    for (int t = 0; t < 2; ++t) { const int m = 2 * mp + t; const f32x4 v0 = acc[ai][bj][m][0] * (F8_SY / (F8_SH * F8_SWD)), v1 = acc[ai][bj][m][1] * (F8_SY / (F8_SH * F8_SWD));
                        wp[t].x = cvt_pk4_fp8(v0[0], v0[1], v0[2], v0[3]); wp[t].y = cvt_pk4_fp8(v1[0], v1[1], v1[2], v1[3]); }
                    const u32x2 s0 = __builtin_amdgcn_permlane16_swap(wp[0].x, wp[1].x, false, false), s1 = __builtin_amdgcn_permlane16_swap(wp[0].y, wp[1].y, false, false);
                    if (myrow < nvalid) __builtin_amdgcn_raw_buffer_store_b128((u32x4){s0.x, s1.x, s0.y, s1.y}, rsO, bo + bj * HALF, 0, 0); } }
    }
};
}

struct Args { const float* in[20]; float* out; unsigned char* ws; int ph_lo, ph_hi; };
enum { I_X = 0, I_META, I_MIXNW, I_WIN, I_CMW, I_CMNW, I_QKVCW, I_ALOG, I_DTB, I_GDNNW, I_WOUT, I_FFNNW, I_WGRP, I_BGRP, I_WRT, I_BRT, I_WG, I_WU, I_WD, I_FINNW };

struct Frame {
    LAS unsigned char* lds;
    unsigned char* ws; unsigned char* dob;
    int tid, lane, wave, G, vcu;
};

constexpr int TR_SCR = 64 * 65 * 4;
struct TileLd { f32x4 v[16]; f32x4 s0, s1; };
__device__ __forceinline__ void tile_load(const float* W, int ldn, const float* kscale, int k0, int n0, int lane, TileLd& t) {
    const int kr = lane >> 4, c4 = lane & 15, kc = lane & 7;
#pragma unroll
    for (int i = 0; i < 16; ++i) t.v[i] = __builtin_nontemporal_load((const f32x4*)(W + (size_t)(k0 + 4 * i + kr) * ldn + n0 + 4 * c4));
    if (kscale) { t.s0 = *(const f32x4*)(kscale + k0 + 8 * kc); t.s1 = *(const f32x4*)(kscale + k0 + 8 * kc + 4); }
    else { t.s0 = (f32x4){1.f, 1.f, 1.f, 1.f}; t.s1 = t.s0; }
}
__device__ __forceinline__ void tile_load_nb(const float* W, int ldn, const float* kscale, const float* anyk, int k0, int n0, int lane, TileLd& t) {
    const int kr = lane >> 4, c4 = lane & 15, kc = lane & 7;
#pragma unroll
    for (int i = 0; i < 16; ++i) t.v[i] = __builtin_nontemporal_load((const f32x4*)(W + (size_t)(k0 + 4 * i + kr) * ldn + n0 + 4 * c4));
    const float* kp = (kscale ? kscale : anyk) + k0 + 8 * kc;
    const f32x4 a0 = *(const f32x4*)kp, a1 = *(const f32x4*)(kp + 4), one = (f32x4){1.f, 1.f, 1.f, 1.f};
    t.s0 = kscale ? a0 : one; t.s1 = kscale ? a1 : one;
}
__device__ __forceinline__ void tile_store_f8(const TileLd& t, int Kout, unsigned char* WT8, LAS float* scr, int k0, int outrow0, int lane, float wsc) {
    const int kr = lane >> 4, c4 = lane & 15;
#pragma unroll
    for (int i = 0; i < 16; ++i) { LAS float* d = scr + (4 * i + kr) * 65 + 4 * c4; d[0] = t.v[i][0]; d[1] = t.v[i][1]; d[2] = t.v[i][2]; d[3] = t.v[i][3]; }
    LDS_WAIT(); asm volatile("" ::: "memory");
    const int kc = lane & 7, nr = lane >> 3;
    const f32x4 s0 = t.s0 * wsc, s1 = t.s1 * wsc;
#pragma unroll
    for (int j = 0; j < 8; ++j) { const int n = nr + 8 * j; const LAS float* q = scr + (8 * kc) * 65 + n;
        u32x2 o; o.x = cvt_pk4_fp8(q[0] * s0[0], q[65] * s0[1], q[130] * s0[2], q[195] * s0[3]); o.y = cvt_pk4_fp8(q[260] * s1[0], q[325] * s1[1], q[390] * s1[2], q[455] * s1[3]);
        __builtin_nontemporal_store(o, (u32x2*)(WT8 + (size_t)(outrow0 + n) * Kout + k0 + 8 * kc)); }
    LDS_WAIT(); asm volatile("" ::: "memory");
}
template <bool NT_STORE> __device__ __forceinline__ void tile_store(const TileLd& t, int Kout, bf16_t* WT, LAS float* scr, int k0, int outrow0, int lane) {
    const int kr = lane >> 4, c4 = lane & 15;
#pragma unroll
    for (int i = 0; i < 16; ++i) { LAS float* d = scr + (4 * i + kr) * 65 + 4 * c4; d[0] = t.v[i][0]; d[1] = t.v[i][1]; d[2] = t.v[i][2]; d[3] = t.v[i][3]; }
    LDS_WAIT(); asm volatile("" ::: "memory");
    const int kc = lane & 7, nr = lane >> 3;
#pragma unroll
    for (int j = 0; j < 8; ++j) { const int n = nr + 8 * j; const LAS float* q = scr + (8 * kc) * 65 + n;
        u32x4 o; o.x = cvt_pk_bf16(q[0] * t.s0[0], q[65] * t.s0[1]); o.y = cvt_pk_bf16(q[130] * t.s0[2], q[195] * t.s0[3]); o.z = cvt_pk_bf16(q[260] * t.s1[0], q[325] * t.s1[1]); o.w = cvt_pk_bf16(q[390] * t.s1[2], q[455] * t.s1[3]);
        if constexpr (NT_STORE) __builtin_nontemporal_store(o, (u32x4*)(WT + (size_t)(outrow0 + n) * Kout + k0 + 8 * kc));
        else *(u32x4*)(WT + (size_t)(outrow0 + n) * Kout + k0 + 8 * kc) = o; }
    LDS_WAIT(); asm volatile("" ::: "memory");
}
template <bool NT_STORE> __device__ __forceinline__ void transpose_tile64(const float* W, int ldn, int Kout, bf16_t* WT, const float* kscale, LAS float* scr, int k0, int n0, int outrow0, int lane) {
    TileLd t; tile_load(W, ldn, kscale, k0, n0, lane, t); tile_store<NT_STORE>(t, Kout, WT, scr, k0, outrow0, lane);
}

__device__ __forceinline__ void p0_prologue(Frame& F, const Args& a) {
    const int gw = F.vcu * 8 + F.wave, NGW = F.G * 8;
    LAS float* scr = (LAS float*)(F.lds + F.wave * TR_SCR);
    LAS float* wab = (LAS float*)(F.lds);
    const float* w_in = a.in[I_WIN]; const float* mixnw = a.in[I_MIXNW];
    bf16_t* WinT = (bf16_t*)(F.ws + WS_WIN); bf16_t* WoutT = (bf16_t*)(F.ws + WS_WOUT);
    constexpr int I_IN = 16 * 56, I_OUT = 16 * 16, I_WR = 32 * 3 * 2;
    for (int it = gw; it < I_IN + I_OUT + I_WR; it += NGW) {
        int r = it;
        if (r < I_IN) { transpose_tile64<false>(w_in, PROJ_LD, DM, WinT, mixnw, scr, 64 * (r / 56), 64 * (r % 56), 64 * (r % 56), F.lane); continue; } r -= I_IN;
        if (r < I_OUT) { transpose_tile64<false>(a.in[I_WOUT], DM, DM, WoutT, nullptr, scr, 64 * (r / 16), 64 * (r % 16), 64 * (r % 16), F.lane); continue; } r -= I_OUT;
        {
            const int ks = r / 6, nt = (r % 6) >> 1, hl = r & 1, j = F.lane & 15, q = F.lane >> 4, c = 16 * nt + j; unsigned pk[4];
#pragma unroll
            for (int jp = 0; jp < 4; ++jp) { float wv[2];
#pragma unroll
                for (int t = 0; t < 2; ++t) { const int k = 32 * ks + 8 * q + 2 * jp + t; float w = 0.f;
                    if (c < 4) w = a.in[I_WGRP][k * 4 + c]; else if (c < 36) w = a.in[I_WRT][k * 32 + (c - 4)];
                    w *= a.in[I_FFNNW][k];
                    const float hi = bf_lo(cvt_pk_bf16(w, 0.f) & 0xffffu); wv[t] = hl ? (w - hi) : hi; }
                pk[jp] = cvt_pk_bf16(wv[0], wv[1]); }
            ((u32x4*)(F.ws + WS_WRF))[(size_t)r * 64 + F.lane] = (u32x4){pk[0], pk[1], pk[2], pk[3]};
        }
    }
    __syncthreads();
    if (F.vcu < 192) {
        const int n0 = 16 * F.vcu, l15 = F.lane & 15, q = F.lane >> 4, kb = 128 * F.wave;
        const float* mrow = a.in[I_META] + (size_t)l15 * DM + kb + q; const float* wcol = w_in + (size_t)(kb + q) * PROJ_LD + n0 + l15;
        float av[32], bv[32];
#pragma unroll
        for (int s4 = 0; s4 < 32; ++s4) { av[s4] = mrow[4 * s4]; bv[s4] = wcol[(size_t)(4 * s4) * PROJ_LD] * mixnw[kb + 4 * s4 + q]; }
        f32x4 acc = (f32x4){0.f, 0.f, 0.f, 0.f}; float ssq = 0.f;
#pragma unroll
        for (int s4 = 0; s4 < 32; ++s4) { ssq += av[s4] * av[s4]; acc = __builtin_amdgcn_mfma_f32_16x16x4f32(av[s4], bv[s4], acc, 0, 0, 0); }
        ssq += __shfl_xor(ssq, 16); ssq += __shfl_xor(ssq, 32);
        LAS float* red = (LAS float*)(F.lds);
#pragma unroll
        for (int rr = 0; rr < 4; ++rr) red[(F.wave * 16 + 4 * q + rr) * 17 + l15] = acc[rr];
        if (q == 0) red[8 * 16 * 17 + F.wave * 16 + l15] = ssq;
        __syncthreads();
        if (F.tid < 256) { const int i = F.tid >> 4, j = F.tid & 15; float v = 0.f, sq = 0.f;
#pragma unroll
            for (int w = 0; w < 8; ++w) { v += red[(w * 16 + i) * 17 + j]; sq += red[8 * 16 * 17 + w * 16 + i]; }
            v *= rsqrtf(sq * (1.f / DM) + EPS);
            bf16_t* dst = (n0 < 1536 ? (bf16_t*)(F.ws + WS_PA) + n0 : (bf16_t*)(F.ws + WS_PQ) + (n0 - 1536)) + j;
            const bf16_t hb = (bf16_t)(cvt_pk_bf16(v, 0.f) & 0xffffu);
            dst[(size_t)(TPAD + i) * 1536] = hb; dst[(size_t)(LP + TPAD + i) * 1536] = hb; }
        __syncthreads();
    }
    for (int i = F.tid; i < 8 * 1024; i += 512) { const int k = i >> 3, c = i & 7; wab[c * 1024 + k] = w_in[(size_t)k * PROJ_LD + NPROJ + c] * mixnw[k]; }
    __syncthreads();
    bf16_t* xb = (bf16_t*)(F.ws + WS_XB); float* rstd1 = (float*)(F.ws + WS_RSTD1); float* gb = (float*)(F.ws + WS_GB);
#define P0_LOAD_ROW(rr, dst) do { const int b_ = (rr) >= LP ? 1 : 0, t_ = (rr) - b_ * LP;     \
        if (t_ >= TPAD) { const float* src_ = t_ < TREAL ? a.in[I_META] + (size_t)(t_ - TPAD) * DM : a.in[I_X] + ((size_t)b_ * SEQ + (t_ - TREAL)) * DM; \
            _Pragma("unroll") for (int j = 0; j < 4; ++j) dst[j] = __builtin_nontemporal_load((const f32x4*)src_ + 64 * j + F.lane); } \
        else { _Pragma("unroll") for (int j = 0; j < 4; ++j) dst[j] = (f32x4){0.f, 0.f, 0.f, 0.f}; } } while (0)
    const float dtb_h = a.in[I_DTB][F.lane & 3], nega_h = -expf(a.in[I_ALOG][F.lane & 3]);
    f32x4 vnx[4];
    int r0 = gw, rstep = NGW, rend = MR;
    if (F.G == 256) {
        if (gw < 1344) { rstep = 1344; rend = 1344 * 6; }
        else if (gw < 1536) { r0 = 1344 * 6 + (gw - 1344); rstep = 192; rend = 1344 * 6 + 192 * 9; }
        else { r0 = 1344 * 6 + 192 * 9 + (gw - 1536); rstep = 512; }
    }
    f32x4 vn2[4];
#pragma unroll
    for (int j = 0; j < 4; ++j) vn2[j] = (f32x4){0.f, 0.f, 0.f, 0.f};
    if (r0 < rend) P0_LOAD_ROW(r0, vnx);
    if (r0 + rstep < rend) P0_LOAD_ROW(r0 + rstep, vn2);
    for (int r = r0; r < rend; r += rstep) {
        const int bq = r >= LP ? 1 : 0, t = r - bq * LP;
        f32x4 v[4];
#pragma unroll
        for (int j = 0; j < 4; ++j) { v[j] = vnx[j]; vnx[j] = vn2[j]; }
        if (r + 2 * rstep < rend) P0_LOAD_ROW(r + 2 * rstep, vn2);
        f32x2_t vl[4], vh[4];
#pragma unroll
        for (int j = 0; j < 4; ++j) { vl[j] = (f32x2_t){v[j][0], v[j][1]}; vh[j] = (f32x2_t){v[j][2], v[j][3]}; }
        f32x2_t sa = vl[0] * vl[0], sb = vh[0] * vh[0];
#pragma unroll
        for (int j = 1; j < 4; ++j) { sa += vl[j] * vl[j]; sb += vh[j] * vh[j]; }
        sa += sb;
        float ss = wave_sum(sa.x + sa.y);
        const float rstd = rsqrtf(ss * (1.f / DM) + EPS);
        if (t >= TREAL) {
            const int m = bq * SEQ + (t - TREAL);
            u32x2* o8 = (u32x2*)(xb + (size_t)m * DM);
#pragma unroll
            for (int j = 0; j < 4; ++j) { u32x2 w; w.x = cvt_pk_bf16(v[j][0] * rstd, v[j][1] * rstd); w.y = cvt_pk_bf16(v[j][2] * rstd, v[j][3] * rstd); o8[64 * j + F.lane] = w; }
            if (F.lane == 0) rstd1[m] = (ss * (1.f / DM) + EPS) * rstd;
        } else if (t < TPAD) {
            u32x4* za = (u32x4*)((bf16_t*)(F.ws + WS_PA) + (size_t)r * 1536); u32x4* zq = (u32x4*)((bf16_t*)(F.ws + WS_PQ) + (size_t)r * 1536);
#pragma unroll
            for (int j = 0; j < 3; ++j) { za[64 * j + F.lane] = (u32x4){0u, 0u, 0u, 0u}; zq[64 * j + F.lane] = (u32x4){0u, 0u, 0u, 0u}; }
        }
        float ab[8];
#pragma unroll
        for (int c = 0; c < 8; ++c) { float s; f32x2_t da, db;
#pragma unroll
            for (int j = 0; j < 4; ++j) { const f32x4 w = *(const LAS f32x4*)(wab + c * 1024 + 256 * j + 4 * F.lane); const f32x2_t wl = (f32x2_t){w[0], w[1]}, wh = (f32x2_t){w[2], w[3]};
                if (j == 0) { da = vl[0] * wl; db = vh[0] * wh; } else { da += vl[j] * wl; db += vh[j] * wh; } }
            da += db; s = da.x + da.y;
            ab[c] = wave_sum(s); }
        if (F.lane < 4) { const int h = F.lane;
            float av = ab[0], bv = ab[4];
            if (h == 1) { av = ab[1]; bv = ab[5]; } else if (h == 2) { av = ab[2]; bv = ab[6]; } else if (h == 3) { av = ab[3]; bv = ab[7]; }
            av *= rstd; bv *= rstd;
            const float z = av + dtb_h;
            const float sp = fmaxf(z, 0.f) + __logf(1.f + __expf(-fabsf(z)));
            float g = nega_h * sp, be = __builtin_amdgcn_rcpf(1.f + __expf(-bv));
            if (t < TPAD) { g = 0.f; be = 0.f; }
            gb[(size_t)r * 8 + h] = g; gb[(size_t)r * 8 + 4 + h] = be; }
    }
#undef P0_LOAD_ROW
}

__device__ __forceinline__ void unpack8(const u32x4 w, float (&f)[8]) { f[0] = bf_lo(w.x); f[1] = bf_hi(w.x); f[2] = bf_lo(w.y); f[3] = bf_hi(w.y); f[4] = bf_lo(w.z); f[5] = bf_hi(w.z); f[6] = bf_lo(w.w); f[7] = bf_hi(w.w); }
__device__ __forceinline__ void p2_mixer_a(Frame& F, const Args& a) {
    if (F.G > 16 && F.vcu < 8) return;
    const int skip = F.G > 16 ? 8 : 0;
    const int gw = (F.vcu - skip) * 8 + F.wave, NGW = (F.G - skip) * 8;
    const bf16_t* PA = (const bf16_t*)(F.ws + WS_PA); bf16_t* YC = (bf16_t*)(F.ws + WS_YCAT);
    const int c0 = 8 * F.lane;
    float w0[8], w1[8], w2[8], nw[8];
#pragma unroll
    for (int i = 0; i < 8; ++i) { w0[i] = a.in[I_CMW][c0 + i]; w1[i] = a.in[I_CMW][512 + c0 + i]; w2[i] = a.in[I_CMW][1024 + c0 + i]; nw[i] = a.in[I_CMNW][c0 + i]; }
    const bool bal = (F.G == 256);
    for (int uu = gw; uu < MT / 8; uu += NGW) {
        int b, s0, nrows;
        if (bal) { const int W = NGW >> 1, ex = SEQ - 8 * W; b = gw >= W ? 1 : 0; const int i = gw - b * W; s0 = i < ex ? 9 * i : 8 * i + ex; nrows = i < ex ? 9 : 8; }
        else { b = uu / (SEQ / 8); s0 = (uu % (SEQ / 8)) * 8; nrows = 8; }
        const size_t r0 = (size_t)b * LP + s0 + TREAL;
        u32x4 gcr[11], uvr[11], gbr[9];
#pragma unroll
        for (int w = 0; w < 10; ++w) { gcr[w] = __builtin_nontemporal_load((const u32x4*)(PA + (r0 - 2 + w) * 1536 + 512 + c0)); uvr[w] = __builtin_nontemporal_load((const u32x4*)(PA + (r0 - 2 + w) * 1536 + 1024 + c0)); }
#pragma unroll
        for (int w = 0; w < 8; ++w) gbr[w] = __builtin_nontemporal_load((const u32x4*)(PA + (r0 + w) * 1536 + c0));
        gcr[10] = (u32x4){0u, 0u, 0u, 0u}; uvr[10] = (u32x4){0u, 0u, 0u, 0u}; gbr[8] = (u32x4){0u, 0u, 0u, 0u};
        float p2[8], p1[8];
        { float gc[8], uv[8]; unpack8(gcr[0], gc); unpack8(uvr[0], uv);
#pragma unroll
          for (int i = 0; i < 8; ++i) p2[i] = gc[i] * uv[i];
          unpack8(gcr[1], gc); unpack8(uvr[1], uv);
#pragma unroll
          for (int i = 0; i < 8; ++i) p1[i] = gc[i] * uv[i]; }
#pragma unroll
        for (int rr = 0; rr < 9; ++rr) {
            if (rr >= nrows) break;
            if (rr == 2 && nrows == 9) { gcr[10] = __builtin_nontemporal_load((const u32x4*)(PA + (r0 + 8) * 1536 + 512 + c0)); uvr[10] = __builtin_nontemporal_load((const u32x4*)(PA + (r0 + 8) * 1536 + 1024 + c0));
                gbr[8] = __builtin_nontemporal_load((const u32x4*)(PA + (r0 + 8) * 1536 + c0)); }
            float gc[8], uv[8], gbv[8], y[8];
            unpack8(gbr[rr], gbv); unpack8(gcr[rr + 2], gc); unpack8(uvr[rr + 2], uv);
            float ss = 0.f;
#pragma unroll
            for (int i = 0; i < 8; ++i) { const float p = gc[i] * uv[i]; y[i] = gbv[i] * (w0[i] * p2[i] + w1[i] * p1[i] + w2[i] * p); p2[i] = p1[i]; p1[i] = p; ss += y[i] * y[i]; }
            ss = sum8(ss);
            const float rs = rsqrtf(ss * (1.f / 64.f) + EPS);
            u32x4 w; w.x = cvt_pk_bf16(y[0] * rs * nw[0], y[1] * rs * nw[1]); w.y = cvt_pk_bf16(y[2] * rs * nw[2], y[3] * rs * nw[3]);
            w.z = cvt_pk_bf16(y[4] * rs * nw[4], y[5] * rs * nw[5]); w.w = cvt_pk_bf16(y[6] * rs * nw[6], y[7] * rs * nw[7]);
            *(u32x4*)(YC + ((size_t)b * SEQ + s0 + rr) * DM + c0) = w;
        }
        if (bal) break;
    }
}

constexpr int P3_Q16 = 0, P3_K16 = 16384, P3_RT = 32768, P3_T16 = 65536, P3_LM = 73728, P3_TF = 91136, P3_XS = 108544, P3_GC = 113152, P3_CW = 114176;
static_assert(P3_CW + 4 * 1536 * 4 <= LDSCTL_OFF, "P3 LDS map");
__device__ __forceinline__ int p3_sw(int row, int chunk) { return row * 256 + ((chunk ^ (row & 15)) << 4); }
__device__ __forceinline__ int p3_sw64(int row, int chunk) { return row * 128 + ((chunk ^ ((row >> 1) & 7)) << 4); }
__device__ __forceinline__ float silu_fast(float x) { return x * __builtin_amdgcn_rcpf(1.f + __expf(-x)); }
__device__ __forceinline__ void unpack8p(const u32x4 w, f32x2_t (&f)[4]) { f[0] = (f32x2_t){bf_lo(w.x), bf_hi(w.x)}; f[1] = (f32x2_t){bf_lo(w.y), bf_hi(w.y)}; f[2] = (f32x2_t){bf_lo(w.z), bf_hi(w.z)}; f[3] = (f32x2_t){bf_lo(w.w), bf_hi(w.w)}; }
__device__ __forceinline__ f32x2_t silu_pk(const f32x2_t x) {
    const f32x2_t t = x * (f32x2_t){-1.4426950408889634f, -1.4426950408889634f};
    const f32x2_t d = (f32x2_t){__builtin_amdgcn_exp2f(t.x), __builtin_amdgcn_exp2f(t.y)} + (f32x2_t){1.f, 1.f};
    return x * (f32x2_t){__builtin_amdgcn_rcpf(d.x), __builtin_amdgcn_rcpf(d.y)}; }
__device__ __forceinline__ void mm16(f32x4& acc, const LAS float* Ab, int lda, const LAS float* Bb, int ldb, int l15, int q) {
#pragma unroll
    for (int s4 = 0; s4 < 4; ++s4) acc = __builtin_amdgcn_mfma_f32_16x16x4f32(Ab[l15 * lda + 4 * s4 + q], Bb[(4 * s4 + q) * ldb + l15], acc, 0, 0, 0);
}
__device__ __forceinline__ void p3_prefetch(Frame& F, const Args& a, int unit, float& pg, float& pbe, u32x4 (&xp)[11]) {
    const int bh = unit / NCHUNK, n = unit % NCHUNK, b = bh >> 2, h = bh & 3, t0 = 64 * n;
    const size_t rbase = (size_t)b * LP + t0;
    const float* gb = (const float*)(F.ws + WS_GB);
    if (F.wave == 4) { pg = gb[(rbase + F.lane) * 8 + h]; pbe = gb[(rbase + F.lane) * 8 + 4 + h]; }
    {
        const bool isv = F.wave >= 4;
        const int ch = F.tid & 15, dk0 = ch * 8, rowb = isv ? 4 * ((F.tid - 256) >> 4) : 8 * ((F.tid >> 4) & 7);
        const int col = (isv ? 1024 : (F.tid >> 7) * 512) + h * 128 + dk0;
        const __amdgpu_buffer_rsrc_t rsq = __builtin_amdgcn_make_buffer_rsrc((void*)(F.ws + WS_PQ), 0, MR * 1536 * 2, 0x00020000);
        const int off0 = ((b * LP + t0 + rowb - 3) * 1536 + col) * 2;
#pragma unroll
        for (int w = 0; w < 11; ++w) {
            if (!(isv && w >= 7)) xp[w] = __builtin_amdgcn_raw_buffer_load_b128(rsq, off0 + w * 3072, 0, 2); else xp[w] = (u32x4){0u, 0u, 0u, 0u}; }
    }
}
__device__ __forceinline__ void p3_phase(Frame& F, const Args& a) {
  float pg = 0.f, pbe = 0.f; u32x4 xp[11];
  int unit = F.vcu;
  if (unit < NUNIT_GDN) p3_prefetch(F, a, unit, pg, pbe, xp);
  { LAS float* cw0 = (LAS float*)(F.lds + P3_CW);
    for (int i = F.tid; i < 4 * 1536; i += 512) cw0[i] = a.in[I_QKVCW][i]; }
  __syncthreads();
  bool first_unit = true;
  for (; unit < NUNIT_GDN; unit += F.G) {
    int vzu; asm volatile("v_mov_b32 %0, 0" : "=v"(vzu));
    const int tid_o = F.tid + vzu, lane_o = tid_o & 63, l15 = lane_o & 15, q = lane_o >> 4;
    LAS unsigned char* L = F.lds + vzu;
    LAS float* gcs = (LAS float*)(L + P3_GC);
    LAS float* Lm = (LAS float*)(L + P3_LM);
    LAS float* Tf = (LAS float*)(L + P3_TF);
    LAS float* Xs = (LAS float*)(L + P3_XS);
    LAS float* cwl = (LAS float*)(L + P3_CW);
    const int bh = unit / NCHUNK, n = unit % NCHUNK, h = bh & 3, t0 = 64 * n;
    unsigned char* gW = F.dob + DO_W + (size_t)unit * 16384; unsigned char* gU = F.dob + DO_U + (size_t)unit * 16384; unsigned char* gQG = F.dob + DO_QG + (size_t)unit * 16384;
    unsigned char* gKD = F.ws + WS_KD + (size_t)unit * 16384; unsigned char* gIN = F.ws + WS_IN + (size_t)unit * 8192;
#define P3_S0(UNIT) do { if (F.wave == 4) { \
        const float g = wave_scan_incl(pg), be = pbe; \
        const float gl = __builtin_bit_cast(float, __builtin_amdgcn_readlane(__builtin_bit_cast(int, g), 63)); \
        gcs[F.lane] = g; gcs[64 + F.lane] = be; gcs[128 + F.lane] = __expf(g); gcs[192 + F.lane] = __expf(gl - g); \
        if (F.lane == 63) ((float*)(F.ws + WS_ALAST))[UNIT] = __expf(g); } } while (0)
    if (first_unit) { P3_S0(unit); __syncthreads(); first_unit = false; }
    {
        const bool isv = F.wave >= 4;
        const int part = isv ? 2 : (F.wave >> 1), rb = (tid_o >> 4) & 7, vb = (tid_o - 256) >> 4, ch = tid_o & 15, dk0 = ch * 8, rowb = isv ? 4 * vb : 8 * rb;
        const int col = part * 512 + h * 128 + dk0;
        f32x2_t cw[4][4];
#pragma unroll
        for (int j = 0; j < 4; ++j) { const f32x4 c0 = *(const LAS f32x4*)(cwl + j * 1536 + col), c1 = *(const LAS f32x4*)(cwl + j * 1536 + col + 4);
            cw[j][0] = (f32x2_t){c0[0], c0[1]}; cw[j][1] = (f32x2_t){c0[2], c0[3]}; cw[j][2] = (f32x2_t){c1[0], c1[1]}; cw[j][3] = (f32x2_t){c1[2], c1[3]}; }
        f32x2_t xw[4][4];
        unpack8p(xp[0], xw[0]); unpack8p(xp[1], xw[1]); unpack8p(xp[2], xw[2]);
        unsigned kdp[4][8], rtp[4][8]; f32x2_t kde[4], rte[4];
        unsigned char* qgb; { const int mt = rb >> 1, ks = dk0 >> 5, r32 = dk0 & 31, half = r32 >> 4, qq = (r32 & 15) >> 2;
            qgb = gQG + ((size_t)((mt * 4 + ks) * 64 + 8 * (rb & 1)) << 4) + half * 8 + (qq << 8); }
#pragma unroll
        for (int rr = 0; rr < 8; ++rr) {
            if (isv && rr >= 4) break;
            const int row = rowb + rr; const bool valid = (t0 + row) >= TPAD;
            f32x2_t o[4]; f32x2_t ss2 = (f32x2_t){0.f, 0.f};
            unpack8p(xp[rr + 3], xw[(rr + 3) & 3]);
#pragma unroll
            for (int i = 0; i < 4; ++i) { f32x2_t c = cw[0][i] * xw[rr & 3][i]; c += cw[1][i] * xw[(rr + 1) & 3][i]; c += cw[2][i] * xw[(rr + 2) & 3][i]; c += cw[3][i] * xw[(rr + 3) & 3][i]; o[i] = c; }
            {
                f32x2_t t[4];
#pragma unroll
                for (int i = 0; i < 4; ++i) t[i] = o[i] * (f32x2_t){-1.4426950408889634f, -1.4426950408889634f};
#pragma unroll
                for (int i = 0; i < 4; ++i) { t[i].x = __builtin_amdgcn_exp2f(t[i].x); t[i].y = __builtin_amdgcn_exp2f(t[i].y); }
#pragma unroll
                for (int i = 0; i < 4; ++i) t[i] += (f32x2_t){1.f, 1.f};
#pragma unroll
                for (int i = 0; i < 4; ++i) { t[i].x = __builtin_amdgcn_rcpf(t[i].x); t[i].y = __builtin_amdgcn_rcpf(t[i].y); }
#pragma unroll
                for (int i = 0; i < 4; ++i) o[i] *= t[i];
            }
            ss2 = o[0] * o[0]; ss2 += o[1] * o[1]; ss2 += o[2] * o[2]; ss2 += o[3] * o[3];
            float ss = ss2.x + ss2.y;
            const float be = gcs[64 + row], eg = gcs[128 + row], ekd = gcs[192 + row];
            if (part < 2) {
                ss = row_sum16(ss);
                float rs = rsqrtf(ss + EPS); if (part == 0) rs *= 0.08838834764831845f; if (!valid) rs = 0.f;
#pragma unroll
                for (int i = 0; i < 4; ++i) o[i] *= (f32x2_t){rs, rs};
                u32x4 w; w.x = cvt_pk_bf16(o[0].x, o[0].y); w.y = cvt_pk_bf16(o[1].x, o[1].y); w.z = cvt_pk_bf16(o[2].x, o[2].y); w.w = cvt_pk_bf16(o[3].x, o[3].y);
                *(LAS u32x4*)(L + (part == 0 ? P3_Q16 : P3_K16) + p3_sw(row, ch)) = w;
                if (part == 0) {
                    const f32x2_t eg2 = (f32x2_t){eg, eg}; const f32x2_t g0 = o[0] * eg2, g1 = o[1] * eg2, g2 = o[2] * eg2, g3 = o[3] * eg2;
                    u32x2 p0, p1; p0.x = cvt_pk_bf16(g0.x, g0.y); p0.y = cvt_pk_bf16(g1.x, g1.y); p1.x = cvt_pk_bf16(g2.x, g2.y); p1.y = cvt_pk_bf16(g3.x, g3.y);
                    *(u32x2*)(qgb + rr * 16) = p0; *(u32x2*)(qgb + 256 + rr * 16) = p1;
                }
            }
            if (part != 0) {
                const float sc = part == 1 ? be * eg : (valid ? be : 0.f);
                if ((rr & 1) == 0) {
#pragma unroll
                    for (int i = 0; i < 4; ++i) rte[i] = o[i] * (f32x2_t){sc, sc};
                } else {
#pragma unroll
                    for (int i = 0; i < 4; ++i) { const f32x2_t b = o[i] * (f32x2_t){sc, sc}; rtp[rr >> 1][2 * i] = cvt_pk_bf16(rte[i].x, b.x); rtp[rr >> 1][2 * i + 1] = cvt_pk_bf16(rte[i].y, b.y); }
                }
                if (part == 1) {
                    if ((rr & 1) == 0) {
#pragma unroll
                        for (int i = 0; i < 4; ++i) kde[i] = o[i] * (f32x2_t){ekd, ekd};
                    } else {
#pragma unroll
                        for (int i = 0; i < 4; ++i) { const f32x2_t a = o[i] * (f32x2_t){ekd, ekd}; kdp[rr >> 1][2 * i] = cvt_pk_bf16(kde[i].x, a.x); kdp[rr >> 1][2 * i + 1] = cvt_pk_bf16(kde[i].y, a.y); }
                    }
                }
            }
        }
        if (part == 1) {
            const int tb = 8 * rb, ks2 = tb >> 5, r32 = tb & 31, half = r32 >> 4, qq = (r32 & 15) >> 2, dt = ch >> 1;
            unsigned char* kdb = gKD + ((size_t)((dt * 2 + ks2) * 64 + 8 * (ch & 1)) << 4) + half * 8 + (qq << 8);
#pragma unroll
            for (int i = 0; i < 8; ++i) { u32x2 p0, p1; p0.x = kdp[0][i]; p0.y = kdp[1][i]; p1.x = kdp[2][i]; p1.y = kdp[3][i];
                *(u32x2*)(kdb + i * 16) = p0; *(u32x2*)(kdb + 256 + i * 16) = p1; }
        }
        if (part == 1) {
#pragma unroll
            for (int i = 0; i < 8; ++i) *(LAS u32x4*)(L + P3_RT + p3_sw64(128 + dk0 + i, rb)) = (u32x4){rtp[0][i], rtp[1][i], rtp[2][i], rtp[3][i]};
        } else if (isv) {
#pragma unroll
            for (int i = 0; i < 8; ++i) *(LAS u32x2*)(L + P3_RT + p3_sw64(dk0 + i, vb >> 1) + (vb & 1) * 8) = (u32x2){rtp[0][i], rtp[1][i]};
        }
    }
    __syncthreads();
#define P3_S2_BODY(PROD) do { const int mt = F.wave & 3; \
        bf16x8 af[4]; \
        _Pragma("unroll") for (int ks = 0; ks < 4; ++ks) af[ks] = *(const LAS bf16x8*)(L + P3_K16 + p3_sw(16 * mt + l15, 4 * ks + q)); \
        _Pragma("unroll") for (int nt = 0; nt < 4; ++nt) { \
            f32x4 d = (f32x4){0.f, 0.f, 0.f, 0.f}; \
            _Pragma("unroll") for (int ks = 0; ks < 4; ++ks) { const bf16x8 bfr = *(const LAS bf16x8*)(L + ((PROD) == 0 ? P3_K16 : P3_Q16) + p3_sw(16 * nt + l15, 4 * ks + q)); d = __builtin_amdgcn_mfma_f32_16x16x32_bf16(af[ks], bfr, d, 0, 0, 0); } \
            const int i = 16 * nt + l15, j0 = 16 * mt + 4 * q; const float gi = gcs[i], bi = gcs[64 + i]; \
            float v[4]; \
            _Pragma("unroll") for (int r = 0; r < 4; ++r) { const int j = j0 + r; const float dec = __expf(fminf(gi - gcs[j], 0.f)); \
                if ((PROD) == 0) v[r] = (i > j) ? bi * d[r] * dec : 0.f; else v[r] = (i >= j) ? d[r] * dec : 0.f; } \
            if ((PROD) == 0) *(LAS f32x4*)(Lm + i * 68 + j0) = (f32x4){v[0], v[1], v[2], v[3]}; \
            else { u32x2 p; p.x = cvt_pk_bf16(v[0], v[1]); p.y = cvt_pk_bf16(v[2], v[3]); \
                *(u32x2*)(gIN + ((size_t)((nt * 2 + (mt >> 1)) * 64 + q * 16 + l15) << 4) + (mt & 1) * 8) = p; } \
        } } while (0)
    if (F.wave < 4) P3_S2_BODY(0);
    { const int un = unit + F.G; if (un < NUNIT_GDN) p3_prefetch(F, a, un, pg, pbe, xp); }
    __syncthreads();
    if (F.wave < 4) {
        const int bb = F.wave; int vz; asm volatile("v_mov_b32 %0, 0" : "=v"(vz));
        const LAS float* Lb = Lm + (16 * bb) * 68 + 16 * bb + vz;
        float av[16]; av[0] = 0.f;
#pragma unroll
        for (int i = 1; i < 16; ++i) { float sacc = -Lb[i * 68 + l15];
#pragma unroll
            for (int jb = 0; jb < (i + 3) / 4; ++jb) { const f32x4 lv = *(const LAS f32x4*)(Lb + i * 68 + 4 * jb);
                if (4 * jb >= 1) sacc -= lv[0] * av[4 * jb]; if (4 * jb + 1 < i) sacc -= lv[1] * av[4 * jb + 1]; if (4 * jb + 2 < i) sacc -= lv[2] * av[4 * jb + 2]; if (4 * jb + 3 < i) sacc -= lv[3] * av[4 * jb + 3]; }
            av[i] = sacc; }
        if (q == 0) {
#pragma unroll
            for (int i = 0; i < 16; ++i) Tf[(16 * bb + i) * 68 + 16 * bb + l15] = av[i] + (i == l15 ? 1.f : 0.f); }
    } else P3_S2_BODY(1);
#undef P3_S2_BODY
    __syncthreads();
    { const int un = unit + F.G; if (un < NUNIT_GDN) P3_S0(un); }
#undef P3_S0
    if (F.wave < 2) {
        const int lo = 2 * F.wave, hi = lo + 1; LAS float* Xp = Xs + F.wave * 16 * 36;
        f32x4 acc = (f32x4){0.f, 0.f, 0.f, 0.f};
        mm16(acc, Lm + (16 * hi) * 68 + 16 * lo, 68, Tf + (16 * lo) * 68 + 16 * lo, 68, l15, q);
#pragma unroll
        for (int r = 0; r < 4; ++r) Xp[(4 * q + r) * 36 + l15] = acc[r];
        LDS_WAIT(); asm volatile("" ::: "memory");
        acc = (f32x4){0.f, 0.f, 0.f, 0.f};
        mm16(acc, Tf + (16 * hi) * 68 + 16 * hi, 68, Xp, 36, l15, q);
#pragma unroll
        for (int r = 0; r < 4; ++r) Tf[(16 * hi + 4 * q + r) * 68 + 16 * lo + l15] = -acc[r];
    }
    __syncthreads();
    if (F.wave < 4) {
        const int bi = F.wave >> 1, bj = F.wave & 1;
        f32x4 acc = (f32x4){0.f, 0.f, 0.f, 0.f};
        if (bj == 0) mm16(acc, Lm + (16 * (2 + bi)) * 68, 68, Tf, 68, l15, q);
        mm16(acc, Lm + (16 * (2 + bi)) * 68 + 16, 68, Tf + 16 * 68 + 16 * bj, 68, l15, q);
#pragma unroll
        for (int r = 0; r < 4; ++r) Xs[(16 * bi + 4 * q + r) * 36 + 16 * bj + l15] = acc[r];
    }
    __syncthreads();
    if (F.wave < 4) {
        const int bi = F.wave >> 1, bj = F.wave & 1;
        f32x4 acc = (f32x4){0.f, 0.f, 0.f, 0.f};
        mm16(acc, Tf + (16 * (2 + bi)) * 68 + 32, 68, Xs + 16 * bj, 36, l15, q);
        if (bi == 1) mm16(acc, Tf + 48 * 68 + 48, 68, Xs + 16 * 36 + 16 * bj, 36, l15, q);
#pragma unroll
        for (int r = 0; r < 4; ++r) Tf[(16 * (2 + bi) + 4 * q + r) * 68 + 16 * bj + l15] = -acc[r];
    }
    __syncthreads();
    {
        const int row = tid_o >> 3, chunk = tid_o & 7;
        u32x4 w = (u32x4){0u, 0u, 0u, 0u};
        if ((chunk >> 1) <= (row >> 4)) { const f32x4 t0v = *(const LAS f32x4*)(Tf + row * 68 + 8 * chunk), t1v = *(const LAS f32x4*)(Tf + row * 68 + 8 * chunk + 4);
            w.x = cvt_pk_bf16(t0v[0], t0v[1]); w.y = cvt_pk_bf16(t0v[2], t0v[3]); w.z = cvt_pk_bf16(t1v[0], t1v[1]); w.w = cvt_pk_bf16(t1v[2], t1v[3]); }
        *(LAS u32x4*)(L + P3_T16 + p3_sw64(row, chunk)) = w;
    }
    __syncthreads();
    {
        const int w8 = F.wave;
        bf16x8 rv[2], rk[2];
#pragma unroll
        for (int k2 = 0; k2 < 2; ++k2) { rv[k2] = *(const LAS bf16x8*)(L + P3_RT + p3_sw64(16 * w8 + l15, 4 * k2 + q)); rk[k2] = *(const LAS bf16x8*)(L + P3_RT + p3_sw64(128 + 16 * w8 + l15, 4 * k2 + q)); }
#pragma unroll
        for (int mt = 0; mt < 4; ++mt) {
            bf16x8 tf[2];
#pragma unroll
            for (int k2 = 0; k2 < 2; ++k2) tf[k2] = *(const LAS bf16x8*)(L + P3_T16 + p3_sw64(16 * mt + l15, 4 * k2 + q));
            f32x4 du = (f32x4){0.f, 0.f, 0.f, 0.f}, dw = (f32x4){0.f, 0.f, 0.f, 0.f};
#pragma unroll
            for (int k2 = 0; k2 < 2; ++k2) { du = __builtin_amdgcn_mfma_f32_16x16x32_bf16(tf[k2], rv[k2], du, 0, 0, 0); dw = __builtin_amdgcn_mfma_f32_16x16x32_bf16(rk[k2], tf[k2], dw, 0, 0, 0); }
            u32x2 pu, pw; pu.x = cvt_pk_bf16(du[0], du[1]); pu.y = cvt_pk_bf16(du[2], du[3]); pw.x = cvt_pk_bf16(-dw[0], -dw[1]); pw.y = cvt_pk_bf16(-dw[2], -dw[3]);
            *(u32x2*)(gU + ((size_t)((w8 * 4 + mt) * 64 + lane_o) << 3)) = pu;
            *(u32x2*)(gW + ((size_t)((mt * 4 + (w8 >> 1)) * 64 + lane_o) << 4) + (w8 & 1) * 8) = pw;
        }
    }
    __syncthreads();
  }
}

__device__ __forceinline__ bf16x8 pack8(const f32x4 a, const f32x4 b) {
    u32x4 w; w.x = cvt_pk_bf16(a[0], a[1]); w.y = cvt_pk_bf16(a[2], a[3]); w.z = cvt_pk_bf16(b[0], b[1]); w.w = cvt_pk_bf16(b[2], b[3]);
    return __builtin_bit_cast(bf16x8, w);
}
__device__ __forceinline__ unsigned lds_ld_u32(unsigned addr) { unsigned v; asm volatile("ds_read_b32 %0, %1\n\ts_waitcnt lgkmcnt(0)" : "=v"(v) : "v"(addr) : "memory"); return v; }
__device__ __forceinline__ void lds_st_u32(unsigned addr, unsigned val) { asm volatile("ds_write_b32 %0, %1" :: "v"(addr), "v"(val) : "memory"); }
template <int J> __device__ __forceinline__ void p4_scan_loader(Frame& F, int bh, int s) {
    constexpr int CNT = J < 4 ? 6 : 5;
    const unsigned ctl = (unsigned)(size_t)(F.lds + SC_CTL);
    const __amdgpu_buffer_rsrc_t rsW = __builtin_amdgcn_make_buffer_rsrc((void*)(F.dob + DO_W), 0, NUNIT_GDN * 16384, 0x00020000), rsK = __builtin_amdgcn_make_buffer_rsrc((void*)(F.ws + WS_KD), 0, NUNIT_GDN * 16384, 0x00020000),
                                 rsU = __builtin_amdgcn_make_buffer_rsrc((void*)(F.dob + DO_U), 0, NUNIT_GDN * 16384, 0x00020000);
    const int lo16 = F.lane * 16;
    for (int n = 0; n < NCHUNK; ++n) {
        if (n >= 4) { unsigned sp = 0; while ((int)lds_ld_u32(ctl + 32) < n - 3) { __builtin_amdgcn_s_sleep(1); if (++sp > (1u << 22)) break; } }
        const int uo = (bh * NCHUNK + n) * 16384;
        LAS unsigned char* slot = F.lds + (n & 3) * SC_SLOT;
#pragma unroll
        for (int i = 0; i < CNT; ++i) { constexpr int dummy = 0; (void)dummy; const int p = J + 6 * i;
            if (p < 16) __builtin_amdgcn_raw_ptr_buffer_load_lds(rsW, (LAS unsigned*)(slot + p * 1024), 16, lo16, uo + p * 1024, 0, 0);
            else if (p < 32) __builtin_amdgcn_raw_ptr_buffer_load_lds(rsK, (LAS unsigned*)(slot + p * 1024), 16, lo16, uo + (p - 16) * 1024, 0, 0);
            else __builtin_amdgcn_raw_ptr_buffer_load_lds(rsU, (LAS unsigned*)(slot + p * 1024), 16, lo16, uo + s * 2048 + (p - 32) * 1024, 0, 0); }
        if (n >= 2) { if constexpr (CNT == 6) asm volatile("s_waitcnt vmcnt(12)" ::: "memory"); else asm volatile("s_waitcnt vmcnt(10)" ::: "memory");
            lds_st_u32(ctl + 4 * J, (unsigned)(n - 1)); }
    }
    if constexpr (CNT == 6) asm volatile("s_waitcnt vmcnt(6)" ::: "memory"); else asm volatile("s_waitcnt vmcnt(5)" ::: "memory");
    lds_st_u32(ctl + 4 * J, (unsigned)(NCHUNK - 1));
    asm volatile("s_waitcnt vmcnt(0)" ::: "memory"); lds_st_u32(ctl + 4 * J, (unsigned)NCHUNK);
}
__device__ __forceinline__ void lds_poll6_gt(unsigned addr, int n) {
    unsigned sp = 0;
    for (;;) { u32x4 v; u32x2 w; asm volatile("ds_read_b128 %0, %2\n\tds_read_b64 %1, %2 offset:16\n\ts_waitcnt lgkmcnt(0)" : "=&v"(v), "=&v"(w) : "v"(addr) : "memory");
        const bool ok = (int)v.x > n && (int)v.y > n && (int)v.z > n && (int)v.w > n && (int)w.x > n && (int)w.y > n;
        if (ok || ++sp > (1u << 24)) break; }
}
__device__ __forceinline__ void p4_scan_c(Frame& F, int bh, int s) {
    const unsigned ctl = (unsigned)(size_t)(F.lds + SC_CTL);
    f32x4 S[8]; bf16x8 Sb[4];
#pragma unroll
    for (int i = 0; i < 8; ++i) S[i] = (f32x4){0.f, 0.f, 0.f, 0.f};
#pragma unroll
    for (int i = 0; i < 4; ++i) Sb[i] = (bf16x8){0, 0, 0, 0, 0, 0, 0, 0};
    const float* alast = (const float*)(F.ws + WS_ALAST) + bh * NCHUNK;
    const float ala = alast[F.lane], alb = alast[64 + F.lane], alc = alast[128];
    unsigned char* sfr = F.ws + WS_SFR + ((size_t)bh * NCHUNK * 8 + s) * 4096 + F.lane * 16;
    const __amdgpu_buffer_rsrc_t sfr_rs = __builtin_amdgcn_make_buffer_rsrc((void*)(F.ws + WS_SFR + ((size_t)bh * NCHUNK * 8 + s) * 4096), 0, NCHUNK * 32768, 0x00020000); const int sfr_vo = F.lane * 16;
    bf16x8 Wr[16]; f32x4 vn[4];
    lds_poll6_gt(ctl, 0);
#pragma unroll
    for (int f = 0; f < 16; ++f) Wr[f] = *(const LAS bf16x8*)(F.lds + f * 1024 + F.lane * 16);
#pragma unroll
    for (int mt = 0; mt < 4; ++mt) { const u32x2 u = *(const LAS u32x2*)(F.lds + 32768 + mt * 512 + F.lane * 8); vn[mt] = (f32x4){bf_lo(u.x), bf_hi(u.x), bf_lo(u.y), bf_hi(u.y)}; }
    float al = 1.f;
    for (int n = 0; n < NCHUNK; ++n) {
        const LAS unsigned char* slot = F.lds + (n & 3) * SC_SLOT + F.lane * 16;
        bf16x8 Kr[16];
#pragma unroll
        for (int f = 0; f < 16; ++f) Kr[f] = *(const LAS bf16x8*)(slot + 16384 + f * 1024);
#pragma unroll
        for (int dt = 0; dt < 8; ++dt) S[dt] = S[dt] * al;
#pragma unroll
        for (int ks = 0; ks < 4; ++ks)
#pragma unroll
            for (int mt = 0; mt < 4; ++mt) vn[mt] = __builtin_amdgcn_mfma_f32_16x16x32_bf16(Wr[mt * 4 + ks], Sb[ks], vn[mt], 0, 0, 0);
#pragma unroll
        for (int ks = 0; ks < 4; ++ks) __builtin_amdgcn_raw_buffer_store_b128(__builtin_bit_cast(u32x4, Sb[ks]), sfr_rs, sfr_vo, n * 32768 + ks * 1024, 0);
        lds_st_u32(ctl + 32, (unsigned)(n + 1));
        bf16x8 Vb[2]; Vb[0] = pack8(vn[0], vn[1]); Vb[1] = pack8(vn[2], vn[3]);
        asm volatile("" : "+v"(S[0]), "+v"(S[1]), "+v"(S[2]), "+v"(S[3]), "+v"(S[4]), "+v"(S[5]), "+v"(S[6]), "+v"(S[7]), "+v"(Vb[0]), "+v"(Vb[1]));
        const int nn = n + 1 < NCHUNK ? n + 1 : NCHUNK - 1;
        lds_poll6_gt(ctl, nn);
        asm volatile("" :: "v"(Kr[15]), "v"(Kr[14]));
        const LAS unsigned char* nslot = F.lds + (nn & 3) * SC_SLOT;
        u32x2 Ur[4];
#pragma unroll
        for (int mt = 0; mt < 4; ++mt) Ur[mt] = *(const volatile LAS u32x2*)(nslot + 32768 + mt * 512 + F.lane * 8);
#pragma unroll
        for (int f = 0; f < 16; ++f) Wr[f] = *(const volatile LAS bf16x8*)(nslot + f * 1024 + F.lane * 16);
#pragma unroll
        for (int k2 = 0; k2 < 2; ++k2)
#pragma unroll
            for (int dt = 0; dt < 8; ++dt) S[dt] = __builtin_amdgcn_mfma_f32_16x16x32_bf16(Kr[dt * 2 + k2], Vb[k2], S[dt], 0, 0, 0);
#pragma unroll
        for (int mt = 0; mt < 4; ++mt) vn[mt] = (f32x4){bf_lo(Ur[mt].x), bf_hi(Ur[mt].x), bf_lo(Ur[mt].y), bf_hi(Ur[mt].y)};
#pragma unroll
        for (int ks = 0; ks < 4; ++ks) Sb[ks] = pack8(S[2 * ks], S[2 * ks + 1]);
        const int n1 = n + 1;
        const float alv = n1 < 64 ? ala : (n1 < 128 ? alb : alc);
        al = __uint_as_float((unsigned)__builtin_amdgcn_readlane((int)__float_as_uint(alv), n1 & 63));
    }
}

constexpr int PO_OT = 40960;
__device__ __forceinline__ void p4_out_phase(Frame& F, const Args& a, const float (&nw)[16]) {
    const int s = F.wave, l15 = F.lane & 15, q = F.lane >> 4;
    const __amdgpu_buffer_rsrc_t rsW = __builtin_amdgcn_make_buffer_rsrc((void*)(F.dob + DO_W), 0, NUNIT_GDN * 16384, 0x00020000), rsQ = __builtin_amdgcn_make_buffer_rsrc((void*)(F.dob + DO_QG), 0, NUNIT_GDN * 16384, 0x00020000),
                                 rsI = __builtin_amdgcn_make_buffer_rsrc((void*)(F.ws + WS_IN), 0, NUNIT_GDN * 8192, 0x00020000);
    const int lo16 = F.lane * 16, row = F.tid >> 3, seg = F.tid & 7;
    bf16x8 Sb[4]; u32x2 Uv[4]; u32x4 zA = (u32x4){0u, 0u, 0u, 0u}, zB = (u32x4){0u, 0u, 0u, 0u};
#define P4_UNIT_OF(U) (((U) >> 7) * NCHUNK + 1 + ((U) & 127))
#define P4_ISSUE(UNIT) do { const int un_ = (UNIT); const int bh_ = un_ / NCHUNK, n_ = un_ % NCHUNK, b_ = bh_ >> 2, h_ = bh_ & 3; \
        _Pragma("unroll") for (int i = 0; i < 5; ++i) { const int p = F.wave + 8 * i;        \
            if (i < 2) __builtin_amdgcn_raw_ptr_buffer_load_lds(rsW, (LAS unsigned*)(F.lds + p * 1024), 16, lo16, un_ * 16384 + p * 1024, 0, 2); \
            else if (i < 4) __builtin_amdgcn_raw_ptr_buffer_load_lds(rsQ, (LAS unsigned*)(F.lds + p * 1024), 16, lo16, un_ * 16384 + (p - 16) * 1024, 0, 2); \
            else __builtin_amdgcn_raw_ptr_buffer_load_lds(rsI, (LAS unsigned*)(F.lds + p * 1024), 16, lo16, un_ * 8192 + (p - 32) * 1024, 0, 2); } \
        { const unsigned char* sfr = F.ws + WS_SFR + ((size_t)un_ * 8 + s) * 4096 + F.lane * 16; \
          _Pragma("unroll") for (int ks = 0; ks < 4; ++ks) Sb[ks] = __builtin_nontemporal_load((const bf16x8*)(sfr + ks * 1024)); \
          const unsigned char* gu = F.dob + DO_U + (size_t)un_ * 16384 + s * 2048 + F.lane * 8; \
          _Pragma("unroll") for (int mt = 0; mt < 4; ++mt) Uv[mt] = __builtin_nontemporal_load((const u32x2*)(gu + mt * 512)); \
          const bf16_t* zp_ = (const bf16_t*)(F.ws + WS_PZ) + ((size_t)b_ * SEQ + 64 * n_ + row - TREAL) * 512 + h_ * 128 + 16 * seg; \
          zA = __builtin_nontemporal_load((const u32x4*)zp_); zB = __builtin_nontemporal_load((const u32x4*)(zp_ + 8)); } } while (0)
    const int UE = 8 * (NCHUNK - 1);
    int u = F.vcu;
    if (u < UE) P4_ISSUE(P4_UNIT_OF(u));
    for (; u < UE; u += F.G) {
    const int unit = P4_UNIT_OF(u);
    const int bh = unit / NCHUNK, n = unit % NCHUNK, b = bh >> 2, h = bh & 3;
    asm volatile("s_waitcnt vmcnt(0)" ::: "memory");
    __syncthreads();
    f32x4 vn[4];
#pragma unroll
    for (int mt = 0; mt < 4; ++mt) vn[mt] = (f32x4){bf_lo(Uv[mt].x), bf_hi(Uv[mt].x), bf_lo(Uv[mt].y), bf_hi(Uv[mt].y)};
    const LAS unsigned char* fl = F.lds + F.lane * 16;
#pragma unroll
    for (int ks = 0; ks < 4; ++ks)
#pragma unroll
        for (int mt = 0; mt < 4; ++mt) vn[mt] = __builtin_amdgcn_mfma_f32_16x16x32_bf16(*(const LAS bf16x8*)(fl + (mt * 4 + ks) * 1024), Sb[ks], vn[mt], 0, 0, 0);
    bf16x8 Vb[2]; Vb[0] = pack8(vn[0], vn[1]); Vb[1] = pack8(vn[2], vn[3]);
    LAS float* OT = (LAS float*)(F.lds + PO_OT);
#pragma unroll
    for (int mt = 0; mt < 4; ++mt) {
        f32x4 o = (f32x4){0.f, 0.f, 0.f, 0.f};
#pragma unroll
        for (int ks = 0; ks < 4; ++ks) o = __builtin_amdgcn_mfma_f32_16x16x32_bf16(*(const LAS bf16x8*)(fl + 16384 + (mt * 4 + ks) * 1024), Sb[ks], o, 0, 0, 0);
#pragma unroll
        for (int k2 = 0; k2 < 2; ++k2) o = __builtin_amdgcn_mfma_f32_16x16x32_bf16(*(const LAS bf16x8*)(fl + 32768 + (mt * 2 + k2) * 1024), Vb[k2], o, 0, 0, 0);
#pragma unroll
        for (int r = 0; r < 4; ++r) OT[(16 * mt + 4 * q + r) * 132 + 16 * s + l15] = o[r];
    }
    const u32x4 zc0 = zA, zc1 = zB;
    __syncthreads();
    { const int un = u + F.G; if (un < UE) P4_ISSUE(P4_UNIT_OF(un)); }
    {
        const int tabs = 64 * n + row;
        const LAS float* orow = OT + row * 132 + 16 * seg;
        float o[16];
#pragma unroll
        for (int i = 0; i < 4; ++i) { const f32x4 v = *(const LAS f32x4*)(orow + 4 * i); o[4 * i] = v[0]; o[4 * i + 1] = v[1]; o[4 * i + 2] = v[2]; o[4 * i + 3] = v[3]; }
        float ss = 0.f;
#pragma unroll
        for (int i = 0; i < 16; ++i) ss += o[i] * o[i];
        ss = sum8(ss);
        {
            const float rs = rsqrtf(ss * (1.f / 128.f) + EPS);
            float z[16]; { float t8[8]; unpack8(zc0, t8);
#pragma unroll
                for (int i = 0; i < 8; ++i) z[i] = t8[i];
                unpack8(zc1, t8);
#pragma unroll
                for (int i = 0; i < 8; ++i) z[8 + i] = t8[i]; }
            float y[16];
#pragma unroll
            for (int i = 0; i < 16; ++i) y[i] = o[i] * rs * nw[i] * silu_f(z[i]);
            bf16_t* yp = (bf16_t*)(F.ws + WS_YCAT) + ((size_t)b * SEQ + tabs - TREAL) * DM + 512 + h * 128 + 16 * seg;
            u32x4 w0, w1; w0.x = cvt_pk_bf16(y[0], y[1]); w0.y = cvt_pk_bf16(y[2], y[3]); w0.z = cvt_pk_bf16(y[4], y[5]); w0.w = cvt_pk_bf16(y[6], y[7]);
            w1.x = cvt_pk_bf16(y[8], y[9]); w1.y = cvt_pk_bf16(y[10], y[11]); w1.z = cvt_pk_bf16(y[12], y[13]); w1.w = cvt_pk_bf16(y[14], y[15]);
            *(u32x4*)yp = w0; *(u32x4*)(yp + 8) = w1;
        }
    }
    }
    __syncthreads();
#undef P4_ISSUE
#undef P4_UNIT_OF
}

struct PeItem { const float* W; const float* ks; unsigned char* WT; int ldn, Kout, k0, n0, orow; float wsc; };
__device__ __forceinline__ PeItem pe_item(const Args& a, unsigned char* WGU, unsigned char* WDN, int it) {
    PeItem p; const int e = it / 384; int r = it % 384;
    if (r < 256) { const int up = r >> 7; r &= 127; p.k0 = 64 * (r >> 3); p.n0 = 64 * (r & 7);
        p.W = a.in[up ? I_WU : I_WG] + (size_t)e * DM * DEXP; p.ldn = DEXP; p.Kout = DM; p.WT = WGU + (size_t)e * DM * DM; p.ks = a.in[I_FFNNW]; p.orow = 256 * (p.n0 >> 7) + 128 * up + (p.n0 & 127); p.wsc = F8_SWG; }
    else { r -= 256; p.k0 = 64 * (r >> 4); p.n0 = 64 * (r & 15);
        p.W = a.in[I_WD] + (size_t)e * DEXP * DM; p.ldn = DM; p.Kout = DEXP; p.WT = WDN + (size_t)e * DM * DEXP; p.ks = nullptr; p.orow = p.n0; p.wsc = F8_SWD; }
    return p;
}
__device__ __forceinline__ void pe_convert(Frame& F, const Args& a, int witem0, int nwaves, int it_begin, int it_end) {
    LAS float* scr = (LAS float*)(F.lds + F.wave * TR_SCR);
    unsigned char* WGU = F.ws + WS_WE; unsigned char* WDN = F.ws + WS_WED;
    const float* anyk = a.in[I_FFNNW];
    int it = it_begin + witem0;
    if (it >= it_end) return;
    PeItem dm; dm.W = anyk; dm.ks = nullptr; dm.WT = WGU; dm.ldn = 0; dm.Kout = DM; dm.k0 = 0; dm.n0 = 0; dm.orow = 0; dm.wsc = 1.f;
    TileLd ta, tb; PeItem pa = pe_item(a, WGU, WDN, it), pb;
    tile_load_nb(pa.W, pa.ldn, pa.ks, anyk, pa.k0, pa.n0, F.lane, ta);
    for (;;) {
        int nx = it + nwaves; const bool mb = nx < it_end;
        pb = mb ? pe_item(a, WGU, WDN, nx) : dm;
        tile_load_nb(pb.W, pb.ldn, pb.ks, anyk, pb.k0, pb.n0, F.lane, tb);
        tile_store_f8(ta, pa.Kout, pa.WT, scr, pa.k0, pa.orow, F.lane, pa.wsc);
        if (!mb) break;
        it = nx; nx = it + nwaves; const bool ma = nx < it_end;
        pa = ma ? pe_item(a, WGU, WDN, nx) : dm;
        tile_load_nb(pa.W, pa.ldn, pa.ks, anyk, pa.k0, pa.n0, F.lane, ta);
        tile_store_f8(tb, pb.Kout, pb.WT, scr, pb.k0, pb.orow, F.lane, pb.wsc);
        if (!ma) break;
        it = nx;
    }
}

constexpr int P6_PART = 0, P6_SS = 98304, P6_HIST = 100352, P6_BASE = 100480, P6_TLO = 100608, P6_THI = 100736, P6_POS = 100864, P6_RS = 101376;
constexpr int CW_TOF = 8192, TOF_LD = 132, CW_TCNT = 12544;
__device__ __forceinline__ void p6_router(Frame& F, const Args& a) {
    const bf16_t* h1 = (const bf16_t*)(F.ws + WS_H1B); const bf16x8* WRF = (const bf16x8*)(F.ws + WS_WRF);
    LAS float* part = (LAS float*)(F.lds + P6_PART); LAS float* ssp = (LAS float*)(F.lds + P6_SS);
    LAS int* hist = (LAS int*)(F.lds + P6_HIST); LAS int* basel = (LAS int*)(F.lds + P6_BASE); LAS int* tlo = (LAS int*)(F.lds + P6_TLO); LAS int* thi = (LAS int*)(F.lds + P6_THI);
    LAS int* posl = (LAS int*)(F.lds + P6_POS);
    unsigned* ctl = (unsigned*)(F.ws + WS_CTL);
    unsigned* gcnt = ctl + CW_CNT; unsigned* tof = ctl + CW_TOF; unsigned* tcnt = ctl + CW_TCNT; int* tile_expert = (int*)(F.ws + WS_TILE);
    bf16_t* XS = (bf16_t*)(F.ws + WS_XS);
    const int l15 = F.lane & 15, q = F.lane >> 4;
    for (int wu = F.vcu; wu < MT / 64; wu += F.G) {
        const int m0 = wu * 64;
        if (F.tid < 32) hist[F.tid] = 0;
        LAS float* bias_l = (LAS float*)(F.lds + P6_RS);
        if (F.tid >= 448 && F.tid < 484) { const int bi = F.tid - 448; bias_l[bi] = bi < 4 ? a.in[I_BGRP][bi] : a.in[I_BRT][bi - 4]; }
        u32x4 ab[4][4]; bf16x8 bw[4][6];
#pragma unroll
        for (int tg = 0; tg < 4; ++tg)
#pragma unroll
            for (int ksl = 0; ksl < 4; ++ksl) ab[tg][ksl] = *(const u32x4*)(h1 + (size_t)(m0 + 16 * tg + l15) * DM + 128 * F.wave + 32 * ksl + 8 * q);
#pragma unroll
        for (int ksl = 0; ksl < 4; ++ksl)
#pragma unroll
            for (int i = 0; i < 6; ++i) bw[ksl][i] = WRF[(size_t)((4 * F.wave + ksl) * 6 + i) * 64 + F.lane];
#pragma unroll
        for (int tg = 0; tg < 4; ++tg) {
            f32x4 acc[3]; acc[0] = acc[1] = acc[2] = (f32x4){0.f, 0.f, 0.f, 0.f}; float ssq = 0.f;
#pragma unroll
            for (int ksl = 0; ksl < 4; ++ksl) {
                float af[8]; unpack8(ab[tg][ksl], af);
#pragma unroll
                for (int i = 0; i < 8; ++i) ssq += af[i] * af[i];
                const bf16x8 av = __builtin_bit_cast(bf16x8, ab[tg][ksl]);
#pragma unroll
                for (int nt = 0; nt < 3; ++nt) { acc[nt] = __builtin_amdgcn_mfma_f32_16x16x32_bf16(av, bw[ksl][2 * nt], acc[nt], 0, 0, 0); acc[nt] = __builtin_amdgcn_mfma_f32_16x16x32_bf16(av, bw[ksl][2 * nt + 1], acc[nt], 0, 0, 0); }
            }
            ssq += __shfl_xor(ssq, 16); ssq += __shfl_xor(ssq, 32);
#pragma unroll
            for (int nt = 0; nt < 3; ++nt)
#pragma unroll
                for (int r = 0; r < 4; ++r) part[((F.wave * 64 + 16 * tg) + 4 * q + r) * 48 + 16 * nt + l15] = acc[nt][r];
            if (q == 0) ssp[F.wave * 64 + 16 * tg + l15] = ssq;
        }
        __syncthreads();
        int e0 = 0, e1 = 0, ls0 = 0, ls1 = 0; float w0 = 0.f, w1 = 0.f, rstd = 0.f;
        if (F.tid < 64) {
            const LAS float* pa = part + F.tid * 48; float sq = 0.f;
#pragma unroll
            for (int w8 = 0; w8 < 8; ++w8) sq += ssp[w8 * 64 + F.tid];
            rstd = rsqrtf(sq * (1.f / DM) + EPS);
            float lg[4]; float mx = -3.0e38f; int gs = 0;
#pragma unroll
            for (int c = 0; c < 4; ++c) { float sv = 0.f;
#pragma unroll
                for (int w8 = 0; w8 < 8; ++w8) sv += pa[w8 * 64 * 48 + c];
                lg[c] = sv * rstd + bias_l[c]; if (lg[c] > mx) { mx = lg[c]; gs = c; } }
            float ps = 0.f;
#pragma unroll
            for (int c = 0; c < 4; ++c) ps += __expf(lg[c] - mx);
            const float pg = 1.f / ps;
            float le[8]; float m1 = -3.0e38f; int i1 = 0;
#pragma unroll
            for (int e = 0; e < 8; ++e) { float sv = 0.f;
#pragma unroll
                for (int w8 = 0; w8 < 8; ++w8) sv += pa[w8 * 64 * 48 + 4 + 8 * gs + e];
                le[e] = sv * rstd + bias_l[4 + 8 * gs + e]; if (le[e] > m1) { m1 = le[e]; i1 = e; } }
            float m2 = -3.0e38f; int i2 = 0;
#pragma unroll
            for (int e = 0; e < 8; ++e) if (e != i1 && le[e] > m2) { m2 = le[e]; i2 = e; }
            const float x2 = __expf(m2 - m1), inv = pg / (1.f + x2);
            w0 = inv; w1 = x2 * inv; e0 = 8 * gs + i1; e1 = 8 * gs + i2;
            ls0 = __hip_atomic_fetch_add(hist + e0, 1, __ATOMIC_RELAXED, __HIP_MEMORY_SCOPE_WORKGROUP);
            ls1 = __hip_atomic_fetch_add(hist + e1, 1, __ATOMIC_RELAXED, __HIP_MEMORY_SCOPE_WORKGROUP);
        }
        __syncthreads();
        if (F.tid < 32) {
            const int e = F.tid, hcnt = hist[e]; int base = 0, t_lo = 0, t_hi = 0;
            if (hcnt) {
                base = (int)__hip_atomic_fetch_add(gcnt + 64 * e, (unsigned)hcnt, RLX_AGENT);
                const int j0 = base >> 8, j1 = (base + hcnt - 1) >> 8;
                if ((base & 255) == 0) { t_lo = (int)__hip_atomic_fetch_add(tcnt, 1u, RLX_AGENT); tile_expert[t_lo] = (j0 << 8) | e; __hip_atomic_store(tof + e * TOF_LD + j0, (unsigned)t_lo + 1u, RLX_AGENT); }
                if (j1 > j0) { t_hi = (int)__hip_atomic_fetch_add(tcnt, 1u, RLX_AGENT); tile_expert[t_hi] = (j1 << 8) | e; __hip_atomic_store(tof + e * TOF_LD + j1, (unsigned)t_hi + 1u, RLX_AGENT); }
                if ((base & 255) != 0) { unsigned v = 0, sp = 0;
                    while ((v = __hip_atomic_load(tof + e * TOF_LD + j0, RLX_AGENT)) == 0u) { __builtin_amdgcn_s_sleep(1); if (++sp > (1u << 22)) break; }
                    t_lo = (int)v - 1; }
            }
            basel[e] = base; tlo[e] = t_lo; thi[e] = t_hi;
        }
        __syncthreads();
        if (F.tid < 64) { const int m = m0 + F.tid;
            const int b0 = basel[e0], s0 = b0 + ls0, b1 = basel[e1], s1 = b1 + ls1;
            const int p0 = 256 * ((s0 >> 8) == (b0 >> 8) ? tlo[e0] : thi[e0]) + (s0 & 255), p1 = 256 * ((s1 >> 8) == (b1 >> 8) ? tlo[e1] : thi[e1]) + (s1 & 255);
            posl[2 * F.tid] = p0; posl[2 * F.tid + 1] = p1;
            ((float*)(F.ws + WS_EW))[2 * m] = w0; ((float*)(F.ws + WS_EW))[2 * m + 1] = w1;
            ((int*)(F.ws + WS_POS))[2 * m] = p0; ((int*)(F.ws + WS_POS))[2 * m + 1] = p1;
            ((float*)(F.ws + WS_RSC))[p0] = rstd; ((float*)(F.ws + WS_RSC))[p1] = rstd;
            ((int*)(F.ws + WS_TOKOF))[p0] = m; ((int*)(F.ws + WS_TOKOF))[p1] = m; }
        __syncthreads();
        __syncthreads();
    }
}

__device__ __forceinline__ void p10_combine(Frame& F, const Args& a, float* outp, int ipa0, int ipa1, float iwa0, float iwa1) {
    const int gw = F.vcu * 8 + F.wave, NGW = F.G * 8;
    const bf16_t* h1 = (const bf16_t*)(F.ws + WS_H1B); const unsigned char* Y = F.ws + WS_XS;
    f32x4 fw[4];
#pragma unroll
    for (int j = 0; j < 4; ++j) fw[j] = ((const f32x4*)a.in[I_FINNW])[64 * j + F.lane];
    const int* POS = (const int*)(F.ws + WS_POS); const float* EW = (const float*)(F.ws + WS_EW);
    int pa0 = 0, pa1 = 0; float wa0 = 0.f, wa1 = 0.f;
    u32x2 vb[4]; unsigned ya[4], yb[4]; float wb0 = 0.f, wb1 = 0.f;
    int m = gw;
    if (m < MT) { pa0 = ipa0; pa1 = ipa1; wa0 = iwa0; wa1 = iwa1; }
#define P10_LOAD_ROWS(mm) do { const u32x2* row_ = (const u32x2*)(h1 + (size_t)(mm) * DM); const unsigned* y0_ = (const unsigned*)(Y + (size_t)pa0 * DM); const unsigned* y1_ = (const unsigned*)(Y + (size_t)pa1 * DM); \
        _Pragma("unroll") for (int j = 0; j < 4; ++j) { vb[j] = __builtin_nontemporal_load(row_ + 64 * j + F.lane); ya[j] = __builtin_nontemporal_load(y0_ + 64 * j + F.lane); yb[j] = __builtin_nontemporal_load(y1_ + 64 * j + F.lane); } wb0 = wa0; wb1 = wa1; } while (0)
    if (m < MT) { P10_LOAD_ROWS(m); const int m1 = m + NGW; if (m1 < MT) { pa0 = POS[2 * m1]; pa1 = POS[2 * m1 + 1]; wa0 = EW[2 * m1]; wa1 = EW[2 * m1 + 1]; } }
    for (; m < MT; m += NGW) {
        f32x4 v[4]; unsigned a0[4], a1[4]; const float w0 = wb0 * (1.f / F8_SY), w1 = wb1 * (1.f / F8_SY);
#pragma unroll
        for (int j = 0; j < 4; ++j) { v[j] = (f32x4){bf_lo(vb[j].x), bf_hi(vb[j].x), bf_lo(vb[j].y), bf_hi(vb[j].y)}; a0[j] = ya[j]; a1[j] = yb[j]; }
        const int m1 = m + NGW, m2 = m + 2 * NGW;
        if (m1 < MT) { P10_LOAD_ROWS(m1); if (m2 < MT) { pa0 = POS[2 * m2]; pa1 = POS[2 * m2 + 1]; wa0 = EW[2 * m2]; wa1 = EW[2 * m2 + 1]; } }
        float ss = 0.f;
#pragma unroll
        for (int j = 0; j < 4; ++j) {
            const f32x2_t p0 = __builtin_amdgcn_cvt_pk_f32_fp8((int)a0[j], false), p1 = __builtin_amdgcn_cvt_pk_f32_fp8((int)a0[j], true);
            const f32x2_t q0 = __builtin_amdgcn_cvt_pk_f32_fp8((int)a1[j], false), q1 = __builtin_amdgcn_cvt_pk_f32_fp8((int)a1[j], true);
            v[j][0] += w0 * p0[0] + w1 * q0[0]; v[j][1] += w0 * p0[1] + w1 * q0[1];
            v[j][2] += w0 * p1[0] + w1 * q1[0]; v[j][3] += w0 * p1[1] + w1 * q1[1];
            ss += (v[j][0] * v[j][0] + v[j][1] * v[j][1]) + (v[j][2] * v[j][2] + v[j][3] * v[j][3]); }
        ss = wave_sum(ss);
        const float rs = rsqrtf(ss * (1.f / DM) + EPS);
#pragma unroll
        for (int j = 0; j < 4; ++j) __builtin_nontemporal_store(v[j] * rs * fw[j], (f32x4*)(outp + (size_t)m * DM) + 64 * j + F.lane);
    }
#undef P10_LOAD_ROWS
}

__global__ void __launch_bounds__(512, 2) mk_fwd(Args args) {
    extern __shared__ __attribute__((aligned(16))) unsigned char lds[];
    Frame F;
    F.lds = (LAS unsigned char*)lds;
    F.tid = threadIdx.x; F.lane = F.tid & 63; F.wave = __builtin_amdgcn_readfirstlane(F.tid >> 6);
    F.G = gridDim.x; { const int bx = blockIdx.x; F.vcu = (F.G % 8 == 0) ? (bx % 8) * (F.G / 8) + bx / 8 : bx; }
    F.ws = args.ws; F.dob = (unsigned char*)args.out;
    volatile LAS unsigned* MISC = (volatile LAS unsigned*)(F.lds + LDSCTL_OFF);
    if (F.tid < 16) MISC[F.tid] = 0u;
    __syncthreads();
    unsigned* ctl = (unsigned*)(F.ws + WS_CTL);
    XcdBarrier bar; bar.bar = ctl + CW_BAR; bar.x = 0; bar.st = nullptr;
    const int lo = args.ph_lo, hi = args.ph_hi;
    const bool use_bar = (hi - lo) > 1;
    const bool self_init = MK_INIT_IN_KERNEL && lo == 0 && hi == NPHASE;
    unsigned long long* magic = (unsigned long long*)(ctl + CW_MAGIC);
    if (self_init) {
        bar.x = xb_xcc_id(); bar.st = MISC + 8;
        if (F.vcu == F.G - 1) {
            u32x4* c4 = (u32x4*)ctl;
            for (int i = F.tid; i < (int)(CTL_ZERO_BYTES / 16); i += 512) c4[i] = (u32x4){0u, 0u, 0u, 0u};
            asm volatile("s_waitcnt vmcnt(0)" ::: "memory");
            __syncthreads();
            if (F.tid == 0) { __builtin_amdgcn_fence(__ATOMIC_RELEASE, "agent"); __hip_atomic_store(magic, CTL_MAGIC, __ATOMIC_RELAXED, __HIP_MEMORY_SCOPE_AGENT); }
        }
    } else if (use_bar) bar = xcd_barrier_post(ctl + CW_BAR, MISC + 8);
#define IN(k) (lo <= (k) && (k) < hi)
#define SCAN_ROLES() do { if (F.wave == 0) p4_scan_c(F, bh, sl); else if (F.wave == 1) p4_scan_loader<0>(F, bh, sl); else if (F.wave == 2) p4_scan_loader<1>(F, bh, sl); else if (F.wave == 3) p4_scan_loader<2>(F, bh, sl); \
    else if (F.wave == 5) p4_scan_loader<3>(F, bh, sl); else if (F.wave == 6) p4_scan_loader<4>(F, bh, sl); else if (F.wave == 7) p4_scan_loader<5>(F, bh, sl); } while (0)
#define REP(k) for (int rep_ = 0; rep_ < 1 + ((MK_REPEAT_MASK >> (k)) & 1); ++rep_)
#define SEAM(k) do { if (IN(k) && IN((k) + 1)) xcd_barrier(bar); } while (0)

    if (IN(0)) REP(0) { p0_prologue(F, args); }
    if (self_init) {
        if (F.tid == 0) { unsigned sp = 0;
            while (__hip_atomic_load(magic, __ATOMIC_RELAXED, __HIP_MEMORY_SCOPE_AGENT) != CTL_MAGIC) { __builtin_amdgcn_s_sleep(4); if (++sp > (1u << 22)) break; }
            (void)xb_add(&bar.bar[XB_XCNT(bar.x)], 1u); }
    }
    SEAM(0);
    if (self_init && F.vcu == F.G - 1 && F.tid == 0) __hip_atomic_store(magic, 0ull, __ATOMIC_RELAXED, __HIP_MEMORY_SCOPE_AGENT);
    if (IN(1)) REP(1) {
        pg8::Gemm g{(const bf16_t*)(F.ws + WS_XB), (const bf16_t*)(F.ws + WS_WIN), DM};
        pg8::DenseOrder S; S.init(MT / 256, 12, DM, F.G, (int)blockIdx.x);
        pg8::EpiProj E{(bf16_t*)(F.ws + WS_PA), (bf16_t*)(F.ws + WS_PQ), (const float*)(F.ws + WS_RSTD1)};
        pg8::gemm_phase<pg8::EpiProj, pg8::DenseOrder>(F.lds, g, S, E);
    }
    SEAM(1);
    if (IN(2)) REP(2) {
        p3_phase(F, args);
#if MK_PROBE_P2 == 1
        p3_phase(F, args);
#endif
        p2_mixer_a(F, args);
#if MK_PROBE_P2 == 2
        p2_mixer_a(F, args);
#endif
    }
    SEAM(2);
    if (IN(3)) REP(3) {
        if (blockIdx.x < 64) {
            if (F.tid < 9) lds_st_u32((unsigned)(size_t)(F.lds + SC_CTL) + 4 * F.tid, 0u);
            __syncthreads();
            const int bh = (int)(blockIdx.x & 7), sl = (int)(blockIdx.x >> 3);
            SCAN_ROLES();
#if MK_PROBE_P3 == 2
            __syncthreads();
            if (F.tid < 9) lds_st_u32((unsigned)(size_t)(F.lds + SC_CTL) + 4 * F.tid, 0u);
            __syncthreads();
            SCAN_ROLES();
#endif
        }
        else {
            const int j = (int)blockIdx.x - 64, nwg = F.G - 64, nz = nwg >= 192 ? 128 : (nwg * 2) / 3, ne = nwg - nz;
            constexpr int NIT = NEXP * 384;
            const int n_early = (int)((long)NIT * 5 / 12);
            if (j < nz) {
                pg8::Gemm g{(const bf16_t*)(F.ws + WS_XB), (const bf16_t*)(F.ws + WS_WIN), DM};
                const int jx = (nz % 8 == 0) ? (j % 8) * (nz / 8) + j / 8 : j;
                pg8::ZOrder S{jx, nz};
                pg8::EpiZ E{(bf16_t*)(F.ws + WS_PZ), (const float*)(F.ws + WS_RSTD1)};
                pg8::gemm_phase<pg8::EpiZ, pg8::ZOrder>(F.lds, g, S, E);
                __syncthreads();
                pe_convert(F, args, j * 8 + F.wave, nz * 8, n_early, NIT);
            } else {
                pe_convert(F, args, (j - nz) * 8 + F.wave, ne * 8, 0, n_early);
            }
        }
    }
    SEAM(3);
    if (IN(4)) REP(4) {
        float nw[16];
#pragma unroll
        for (int i = 0; i < 16; ++i) nw[i] = args.in[I_GDNNW][16 * (F.tid & 7) + i];
        p4_out_phase(F, args, nw);
    }
    SEAM(4);
    if (IN(5)) REP(5) {
        pg8::Gemm g{(const bf16_t*)(F.ws + WS_YCAT), (const bf16_t*)(F.ws + WS_WOUT), DM};
        pg8::DenseOrderPub S; S.init(MT / 256, DM / 256, DM, F.G, (int)blockIdx.x); S.pc = (unsigned*)(F.ws + WS_CTL) + CW_PC;
        pg8::EpiRes E{(const bf16_t*)(F.ws + WS_XB), (bf16_t*)(F.ws + WS_H1B), F.ws + WS_H8, (const float*)(F.ws + WS_RSTD1)};
        pg8::gemm_phase<pg8::EpiRes, pg8::DenseOrderPub>(F.lds, g, S, E);
    }
    const bool p6_counted = (F.G == MT / 64);
    if (!p6_counted) SEAM(5);
    if (IN(6)) {
        if (p6_counted) {
            if (F.tid < 64) { const unsigned* pc = (const unsigned*)(F.ws + WS_CTL) + CW_PC + (F.vcu >> 2) * HC_LD; unsigned sp = 0;
                while ((unsigned)__builtin_amdgcn_readfirstlane((int)__hip_atomic_load(pc, __ATOMIC_RELAXED, __HIP_MEMORY_SCOPE_AGENT)) < 32u) { __builtin_amdgcn_s_sleep(2); if (++sp > (1u << 22)) break; }
                __builtin_amdgcn_fence(__ATOMIC_ACQUIRE, "agent");
                asm volatile("s_waitcnt vmcnt(0)" ::: "memory"); }
            __syncthreads(); }
        p6_router(F, args); }
    SEAM(6);
    LAS int* tile_l = (LAS int*)(F.lds + LDS_TILE_OFF);
    LAS int* tval_l = (LAS int*)(F.lds + LDS_TVAL_OFF); LAS int* tord_l = (LAS int*)(F.lds + LDS_TORD_OFF);
    if (IN(8) || IN(9)) {
        LAS int* cnt_l = (LAS int*)F.lds; LAS int* pre_l = cnt_l + 32;
        int pk = 0;
        if (F.tid < 255) pk = ld_agent((const int*)(F.ws + WS_TILE) + F.tid);
        else if (F.tid == 255) tile_l[255] = (int)ld_agent((const unsigned*)(F.ws + WS_CTL) + CW_TCNT);
        else if (F.tid < 288) cnt_l[F.tid - 256] = (int)ld_agent((const unsigned*)(F.ws + WS_CTL) + CW_CNT + 64 * (F.tid - 256));
        __syncthreads();
        if (F.tid == 0) { int run = 0;
            for (int e = 0; e < NEXP; ++e) { pre_l[e] = run; run += (cnt_l[e] + 255) >> 8; } }
        __syncthreads();
        { const int nt_ = tile_l[255];
          if (F.tid < 255) { int te = 0, tv = 0;
              if (F.tid < nt_) { te = pk & 31; const int j = pk >> 8; const int cnt = cnt_l[te] - 256 * j; tv = cnt < 0 ? 0 : (cnt > 256 ? 256 : cnt);
                  const int rk = pre_l[te] + j; if (rk >= 0 && rk < 255) tord_l[rk] = F.tid; }
              tile_l[F.tid] = te; tval_l[F.tid] = tv; } }
        __syncthreads(); }
    if (IN(8)) REP(8) {
        pg8::Gemm g{(const bf16_t*)(F.ws + WS_H8), (const bf16_t*)(F.ws + WS_WE), DM / 2};
        pg8::MoeOrder S{tile_l, tord_l, tile_l[255], 4, F.G, F.vcu, 256u * DM, (unsigned)DM * DM, (unsigned*)(F.ws + WS_CTL) + CW_HC, (const int*)(F.ws + WS_TOKOF), tval_l};
        pg8::EpiGU E{F.ws + WS_HID, (const float*)(F.ws + WS_RSC), tval_l};
        pg8::gemm_phase<pg8::EpiGU, pg8::MoeOrder>(F.lds, g, S, E);
    }
    if (IN(9)) REP(9) {
        pg8::Gemm g{(const bf16_t*)(F.ws + WS_HID), (const bf16_t*)(F.ws + WS_WED), DEXP / 2};
        const int U8 = 4 * tile_l[255];
        pg8::MoeOrderDown S{tile_l, tord_l, U8, F.G, F.vcu, U8 % F.G, 256u * DEXP, (unsigned)DM * DEXP, (const unsigned*)(F.ws + WS_CTL) + CW_HC, (unsigned*)(F.ws + WS_CTL) + CW_BAR + XB_TMO, tval_l};
        pg8::EpiBf16 E{F.ws + WS_XS, DM, tval_l};
        pg8::gemm_phase<pg8::EpiBf16, pg8::MoeOrderDown>(F.lds, g, S, E);
    }
    int q10a = 0, q10b = 0; float w10a = 0.f, w10b = 0.f;
    if (IN(10)) { const int m = F.vcu * 8 + F.wave; if (m < MT) { q10a = ((const int*)(F.ws + WS_POS))[2 * m]; q10b = ((const int*)(F.ws + WS_POS))[2 * m + 1]; w10a = ((const float*)(F.ws + WS_EW))[2 * m]; w10b = ((const float*)(F.ws + WS_EW))[2 * m + 1]; } }
    SEAM(9);
    if (IN(10)) { if ((MK_REPEAT_MASK >> 10) & 1) p10_combine(F, args, (float*)(F.ws + WS_WE), q10a, q10b, w10a, w10b); p10_combine(F, args, (float*)F.dob, q10a, q10b, w10a, w10b); }
#undef IN
#undef REP
#undef SEAM
}

extern "C" void kernel_launch(void* const* d_in, const int* in_sizes, int n_in, void* d_out, int out_size, void* d_ws, size_t ws_size, hipStream_t stream) {
    static int grid = 0;
    if (grid == 0) {
        if (n_in != 20 || out_size != MT * DM || ws_size < WS_END) { fprintf(stderr, "kernel_launch: unexpected shapes (n_in %d, out %d, ws %zu)\n", n_in, out_size, ws_size); grid = -1; return; }
        int dev = 0, cus = 0, per_cu = 0;
        if (hipGetDevice(&dev) != hipSuccess || hipDeviceGetAttribute(&cus, hipDeviceAttributeMultiprocessorCount, dev) != hipSuccess) { grid = -1; return; }
        if (hipFuncSetAttribute((const void*)mk_fwd, hipFuncAttributeMaxDynamicSharedMemorySize, LDS_BYTES) != hipSuccess) { grid = -1; return; }
        if (hipOccupancyMaxActiveBlocksPerMultiprocessor(&per_cu, (const void*)mk_fwd, 512, LDS_BYTES) != hipSuccess || per_cu < 1) { fprintf(stderr, "kernel_launch: occupancy query says %d\n", per_cu); }
        (void)hipGetLastError();
        grid = cus;
        if (grid < 64) { grid = -1; return; }
    }
    if (grid < 0) return;
    if (!(MK_INIT_IN_KERNEL && MK_N_LAUNCHES == 1)) (void)hipMemsetAsync((char*)d_ws + WS_CTL, 0, CTL_ZERO_BYTES, stream);
    Args a{};
    for (int i = 0; i < 20; ++i) a.in[i] = (const float*)d_in[i];
    a.out = (float*)d_out; a.ws = (unsigned char*)d_ws;
    if (MK_N_LAUNCHES == 1) { a.ph_lo = 0; a.ph_hi = NPHASE; hipLaunchKernelGGL(mk_fwd, dim3(grid), dim3(512), LDS_BYTES, stream, a); }
    else for (int p = 0; p < NPHASE; ++p) { a.ph_lo = p; a.ph_hi = p + 1; hipLaunchKernelGGL(mk_fwd, dim3(grid), dim3(512), LDS_BYTES, stream, a); }
}
```
